# Optimizing an MI355X kernel written in HIP

```python
import jax, jax.numpy as jnp
from jax import lax
import numpy as np

D_MODEL = 1024
BATCH = 2
SEQ = 8192
DEPTH = 1

MLA_HEADS = 8
MLA_Q_LORA = 256
MLA_KV_LORA = 256
MLA_NOPE = 64
MLA_ROPE = 32
MLA_V = 64
ROPE_THETA = 10000.0
DIL_PAIRS = ((128, 1), (512, 4), (2048, 16))
DIL_GROUPS = 3
DIL_HEADS_PER_GROUP = 4
DIL_HEAD_DIM = 128
DIL_HEADS = DIL_GROUPS * DIL_HEADS_PER_GROUP
MEM_LEN = 256
MEM_HEADS = 4
MEM_HEAD_DIM = 128
D_FF = 2816
N_BRANCHES = 3
Q_BLOCK = 128
EPS = 1e-5
ALPHA = (2 * DEPTH) ** 0.25
BETA = (8 * DEPTH) ** -0.25

MLA_OUT = MLA_HEADS * MLA_V
DIL_OUT = DIL_HEADS_PER_GROUP * DIL_HEAD_DIM
DIL_QKV = 3 * DIL_HEADS * DIL_HEAD_DIM
MEM_OUT = MEM_HEADS * MEM_HEAD_DIM
GATE_COLS = N_BRANCHES * D_MODEL
IN_SPLITS = (MLA_Q_LORA, MLA_KV_LORA, MLA_ROPE, DIL_QKV, MEM_OUT, GATE_COLS)
IN_COLS = MLA_Q_LORA + MLA_KV_LORA + MLA_ROPE + DIL_QKV + MEM_OUT + GATE_COLS

kernel_name = "hybrid_gated_mla_dilated_mem_encoder"


def layer_norm(x, g, b):
    xf = x.astype(jnp.float32)
    mu = jnp.mean(xf, -1, keepdims=True)
    var = jnp.mean(jnp.square(xf - mu), -1, keepdims=True)
    y = (xf - mu) * lax.rsqrt(var + EPS) * g.astype(jnp.float32) + b.astype(jnp.float32)
    return y.astype(x.dtype)


def rms_norm(x, g):
    xf = x.astype(jnp.float32)
    y = xf * lax.rsqrt(jnp.mean(jnp.square(xf), -1, keepdims=True) + EPS) * g.astype(jnp.float32)
    return y.astype(x.dtype)


def swiglu(x, w_gate, w_up, w_down):
    return (jax.nn.silu(x @ w_gate) * (x @ w_up)) @ w_down


def rope_tables(seq_len):
    pos = jnp.arange(seq_len, dtype=jnp.float32)
    inv = 1.0 / (ROPE_THETA ** (jnp.arange(0, MLA_ROPE, 2, dtype=jnp.float32) / MLA_ROPE))
    ang = pos[:, None] * inv[None, :]
    return jnp.cos(ang), jnp.sin(ang)


def apply_rope(x, cos, sin):
    cos = cos.astype(x.dtype)
    sin = sin.astype(x.dtype)
    x1, x2 = jnp.split(x, 2, axis=-1)
    return jnp.concatenate([x1 * cos - x2 * sin, x1 * sin + x2 * cos], axis=-1)


def mla_attention(c_q, c_kv, k_rope, q_norm_g, kv_norm_g, w_uq, w_ukv, cos, sin):
    B, S, _ = c_q.shape
    q = (rms_norm(c_q, q_norm_g) @ w_uq).reshape(B, S, MLA_HEADS, MLA_NOPE + MLA_ROPE)
    q_nope, q_pe = q[..., :MLA_NOPE], q[..., MLA_NOPE:]
    q_pe = apply_rope(q_pe, cos[:, None, :], sin[:, None, :])
    kv = (rms_norm(c_kv, kv_norm_g) @ w_ukv).reshape(B, S, MLA_HEADS, MLA_NOPE + MLA_V)
    k_nope, v = kv[..., :MLA_NOPE], kv[..., MLA_NOPE:]
    k_pe = apply_rope(k_rope, cos, sin)
    scale = (MLA_NOPE + MLA_ROPE) ** -0.5
    nb = S // Q_BLOCK
    qn = q_nope.reshape(B, nb, Q_BLOCK, MLA_HEADS, MLA_NOPE).transpose(1, 0, 2, 3, 4)
    qp = q_pe.reshape(B, nb, Q_BLOCK, MLA_HEADS, MLA_ROPE).transpose(1, 0, 2, 3, 4)

    def block(args):
        qn_b, qp_b = args
        s = (jnp.einsum('bqhd,bkhd->bhqk', qn_b, k_nope)
             + jnp.einsum('bqhr,bkr->bhqk', qp_b, k_pe)).astype(jnp.float32) * scale
        p = jax.nn.softmax(s, axis=-1)
        return jnp.einsum('bhqk,bkhd->bqhd', p.astype(v.dtype), v)

    o = lax.map(block, (qn, qp))
    return o.transpose(1, 0, 2, 3, 4).reshape(B, S, MLA_OUT)


def dilated_group(q, k, v, slopes, window, dilation):
    B, S, Hg, Dh = q.shape
    half = window // 2
    n_side = half // dilation
    offs = jnp.arange(-n_side, n_side + 1, dtype=jnp.int32) * dilation
    kp = jnp.pad(k, ((0, 0), (half, half), (0, 0), (0, 0)))
    vp = jnp.pad(v, ((0, 0), (half, half), (0, 0), (0, 0)))
    alibi = -slopes[:, None] * jnp.abs(offs).astype(jnp.float32)[None, :]
    scale = Dh ** -0.5
    nb = S // Q_BLOCK
    qb = q.reshape(B, nb, Q_BLOCK, Hg, Dh).transpose(1, 0, 2, 3, 4)

    def block(args):
        i, q_blk = args
        pos = i * Q_BLOCK + jnp.arange(Q_BLOCK, dtype=jnp.int32)
        kpos = pos[:, None] + offs[None, :]
        valid = (kpos >= 0) & (kpos < S)
        kg = jnp.take(kp, kpos + half, axis=1)
        vg = jnp.take(vp, kpos + half, axis=1)
        s = jnp.einsum('bqhd,bqjhd->bhqj', q_blk, kg).astype(jnp.float32) * scale + alibi[None, :, None, :]
        s = jnp.where(valid[None, None], s, -jnp.inf)
        m = jnp.max(s, axis=-1, keepdims=True)
        e = jnp.exp(s - m)
        den = jnp.sum(e, axis=-1, keepdims=True)
        o = jnp.einsum('bhqj,bqjhd->bqhd', (e / den).astype(v.dtype), vg)
        lse = (m + jnp.log(den))[..., 0].transpose(0, 2, 1)
        return o, lse

    o, lse = lax.map(block, (jnp.arange(nb, dtype=jnp.int32), qb))
    o = o.transpose(1, 0, 2, 3, 4).reshape(B, S, Hg, Dh)
    lse = lse.transpose(1, 0, 2, 3).reshape(B, S, Hg)
    return o, lse


def dilated_attention(dil_cols):
    B, S, _ = dil_cols.shape
    qkv = dil_cols.reshape(B, S, 3, DIL_GROUPS, DIL_HEADS_PER_GROUP, DIL_HEAD_DIM)
    slopes = (2.0 ** (-8.0 * jnp.arange(1, DIL_HEADS + 1, dtype=jnp.float32) / DIL_HEADS)).reshape(
        DIL_GROUPS, DIL_HEADS_PER_GROUP)
    outs, lses = [], []
    for g, (window, dilation) in enumerate(DIL_PAIRS):
        o, lse = dilated_group(qkv[:, :, 0, g], qkv[:, :, 1, g], qkv[:, :, 2, g], slopes[g], window, dilation)
        outs.append(o)
        lses.append(lse)
    w = jax.nn.softmax(jnp.stack(lses, 0), axis=0)
    o = jnp.sum(w[..., None].astype(dil_cols.dtype) * jnp.stack(outs, 0), axis=0)
    return o.reshape(B, S, DIL_OUT)


def memory_attention(q_cols, mem, w_mem_kv):
    B, S, _ = q_cols.shape
    M = mem.shape[1]
    q = q_cols.reshape(B, S, MEM_HEADS, MEM_HEAD_DIM)
    kv = (mem @ w_mem_kv).reshape(B, M, 2, MEM_HEADS, MEM_HEAD_DIM)
    k, v = kv[:, :, 0], kv[:, :, 1]
    s = jnp.einsum('bshd,bmhd->bhsm', q, k).astype(jnp.float32) * (MEM_HEAD_DIM ** -0.5)
    p = jax.nn.softmax(s, axis=-1)
    return jnp.einsum('bhsm,bmhd->bshd', p.astype(v.dtype), v).reshape(B, S, MEM_OUT)


def token_mixing(u, mem, w_in, q_norm_g, kv_norm_g, w_uq, w_ukv, w_mem_kv,
                 w_br_mla, w_br_dil, w_br_mem, w_o, cos, sin):
    B, S, D = u.shape
    proj = u @ w_in
    c_q, c_kv, k_rope, dil_cols, memq_cols, gate_cols = jnp.split(
        proj, [int(i) for i in np.cumsum(IN_SPLITS)[:-1]], axis=-1)
    y_a = mla_attention(c_q, c_kv, k_rope, q_norm_g, kv_norm_g, w_uq, w_ukv, cos, sin) @ w_br_mla
    y_b = dilated_attention(dil_cols) @ w_br_dil
    y_c = memory_attention(memq_cols, mem, w_mem_kv) @ w_br_mem
    gates = jax.nn.sigmoid(gate_cols.astype(jnp.float32)).astype(u.dtype).reshape(B, S, N_BRANCHES, D)
    merged = gates[:, :, 0] * y_a + gates[:, :, 1] * y_b + gates[:, :, 2] * y_c
    return merged @ w_o


def setup_inputs(seed: int = 0) -> dict:
    key = jax.random.key(seed)
    ks = jax.random.split(key, 24)
    f32 = jnp.float32

    def nrm(k, shape, fan_in, gain=1.0):
        return jax.random.normal(k, shape, f32) * (fan_in ** -0.5) * gain

    def gain(k, shape):
        return 1.0 + 0.01 * jax.random.normal(k, shape, f32)

    def bias(k, shape):
        return 0.01 * jax.random.normal(k, shape, f32)

    L, D = DEPTH, D_MODEL
    return {
        "x": jax.random.normal(ks[0], (BATCH, SEQ, D), f32),
        "mem": jax.random.normal(ks[1], (BATCH, MEM_LEN, D), f32),
        "w_in": nrm(ks[2], (L, D, IN_COLS), D),
        "mla_q_norm": gain(ks[3], (L, MLA_Q_LORA)),
        "mla_kv_norm": gain(ks[4], (L, MLA_KV_LORA)),
        "w_uq": nrm(ks[5], (L, MLA_Q_LORA, MLA_HEADS * (MLA_NOPE + MLA_ROPE)), MLA_Q_LORA),
        "w_ukv": nrm(ks[6], (L, MLA_KV_LORA, MLA_HEADS * (MLA_NOPE + MLA_V)), MLA_KV_LORA),
        "w_mem_kv": nrm(ks[7], (L, D, 2 * MEM_OUT), D),
        "w_br_mla": nrm(ks[8], (L, MLA_OUT, D), MLA_OUT),
        "w_br_dil": nrm(ks[9], (L, DIL_OUT, D), DIL_OUT),
        "w_br_mem": nrm(ks[10], (L, MEM_OUT, D), MEM_OUT),
        "w_o": nrm(ks[11], (L, D, D), D, BETA),
        "ffn1_w_gate": nrm(ks[12], (L, D, D_FF), D),
        "ffn1_w_up": nrm(ks[13], (L, D, D_FF), D),
        "ffn1_w_down": nrm(ks[14], (L, D_FF, D), D_FF, BETA),
        "ffn2_w_gate": nrm(ks[15], (L, D, D_FF), D),
        "ffn2_w_up": nrm(ks[16], (L, D, D_FF), D),
        "ffn2_w_down": nrm(ks[17], (L, D_FF, D), D_FF, BETA),
        "ln1_g": gain(ks[18], (L, D)),
        "ln1_b": bias(ks[19], (L, D)),
        "ln2_g": gain(ks[20], (L, D)),
        "ln2_b": bias(ks[21], (L, D)),
        "ln3_g": gain(ks[22], (L, D)),
        "ln3_b": bias(ks[23], (L, D)),
    }


def reference(x, mem, w_in, mla_q_norm, mla_kv_norm, w_uq, w_ukv, w_mem_kv,
              w_br_mla, w_br_dil, w_br_mem, w_o,
              ffn1_w_gate, ffn1_w_up, ffn1_w_down, ffn2_w_gate, ffn2_w_up, ffn2_w_down,
              ln1_g, ln1_b, ln2_g, ln2_b, ln3_g, ln3_b):
    cos, sin = rope_tables(x.shape[1])
    h = x
    for l in range(DEPTH):
        h = layer_norm(ALPHA * h + 0.5 * swiglu(h, ffn1_w_gate[l], ffn1_w_up[l], ffn1_w_down[l]),
                       ln1_g[l], ln1_b[l])
        mix = token_mixing(h, mem, w_in[l], mla_q_norm[l], mla_kv_norm[l], w_uq[l], w_ukv[l], w_mem_kv[l],
                           w_br_mla[l], w_br_dil[l], w_br_mem[l], w_o[l], cos, sin)
        h = layer_norm(ALPHA * h + mix, ln2_g[l], ln2_b[l])
        h = layer_norm(ALPHA * h + 0.5 * swiglu(h, ffn2_w_gate[l], ffn2_w_up[l], ffn2_w_down[l]),
                       ln3_g[l], ln3_b[l])
    return h
```

```cpp
#include <hip/hip_runtime.h>
#include <hip/hip_bf16.h>
#include <cstdio>
#include <cstdint>
#include <cmath>

#ifndef MK_PER_PHASE
#define MK_PER_PHASE 0
#endif
#ifndef MK_PHASE_MASK
#define MK_PHASE_MASK 0xFFFFFFFFu
#endif
#ifndef MK_ATT_MASK
#define MK_ATT_MASK 7
#endif
#ifndef MK_PH_END
#define MK_PH_END 18
#endif

constexpr int D = 1024, BATCH = 2, SEQ = 8192, M = BATCH * SEQ, DFF = 2816;
constexpr int IN_COLS = 8736;
constexpr int NWIN = 5888;
constexpr float LN_EPS = 1e-5f;
constexpr float ALPHA = 1.189207115002721f;
constexpr float LOG2E = 1.4426950408889634f;
constexpr float C96 = 0.10206207261596575f * LOG2E;
constexpr float C128 = 0.08838834764831845f * LOG2E;

constexpr size_t MiB = 1u << 20;
constexpr size_t WS_CTL = 0, CTL_ZERO_BYTES = 1 * MiB;
constexpr size_t WS_ROPE = 1 * MiB;
constexpr size_t WS_SSQ = 2 * MiB, WS_SSKV = 2 * MiB + 128 * 1024;
constexpr size_t WS_LSE = 2 * MiB + 512 * 1024;
constexpr size_t WS_MEMB = 3 * MiB;
constexpr size_t WS_MEMK = 4 * MiB, WS_MEMV = 4 * MiB + 512 * 1024;
constexpr size_t WS_WGU = 5 * MiB;
constexpr size_t WS_WD = 16 * MiB;
constexpr size_t WS_WIN = 22 * MiB;
constexpr size_t WS_WING = 22 * MiB + (size_t)NWIN * 2048;
constexpr size_t WS_WUQ = 40 * MiB;
constexpr size_t WS_WUKV = 40 * MiB + 512 * 1024;
constexpr size_t WS_WMKV = 41 * MiB;
constexpr size_t WS_WBR = 43 * MiB;
constexpr size_t WS_WO = 46 * MiB;
constexpr size_t WS_AB = 48 * MiB;
constexpr size_t WS_H = 80 * MiB;
constexpr size_t WS_DIL = 80 * MiB;
constexpr size_t WS_Q = 152 * MiB;
constexpr size_t WS_KN = 164 * MiB;
constexpr size_t WS_V = 172 * MiB;
constexpr size_t WS_CQ = 180 * MiB, WS_CKV = 184 * MiB;
constexpr size_t WS_KPE = 188 * MiB;
constexpr size_t WS_OCAT = 208 * MiB;
constexpr size_t WS_GATES = 80 * MiB;
constexpr size_t WS_MERGED = 176 * MiB;
constexpr size_t WS_END = 256 * MiB;

constexpr int RING_BYTES = 131072;
constexpr int MISC_OFF = RING_BYTES + 320;
constexpr int LDS_BYTES = 147456;

#define GAS __attribute__((address_space(1)))
#define LAS __attribute__((address_space(3)))
typedef unsigned short bf16_t;
typedef short bf16x8 __attribute__((ext_vector_type(8)));
typedef short s16x4 __attribute__((ext_vector_type(4)));
typedef float f32x4 __attribute__((ext_vector_type(4)));
typedef float f32x2 __attribute__((ext_vector_type(2)));
typedef float f32x16 __attribute__((ext_vector_type(16)));
typedef unsigned u32x4 __attribute__((ext_vector_type(4)));
typedef unsigned u32x2 __attribute__((ext_vector_type(2)));

__device__ __forceinline__ unsigned f2bf(float f) { unsigned u = __builtin_bit_cast(unsigned, f); return (u + 0x7fffu + ((u >> 16) & 1u)) >> 16; }
__device__ __forceinline__ unsigned pk2(float lo, float hi) { return f2bf(lo) | (f2bf(hi) << 16); }
__device__ __forceinline__ unsigned cvt_pk_bf16(float lo, float hi) { unsigned r; asm volatile("v_cvt_pk_bf16_f32 %0, %1, %2" : "=v"(r) : "v"(lo), "v"(hi)); return r; }
__device__ __forceinline__ float bf_lo(unsigned w) { return __builtin_bit_cast(float, w << 16); }
__device__ __forceinline__ float bf_hi(unsigned w) { return __builtin_bit_cast(float, w & 0xffff0000u); }
__device__ __forceinline__ float shx(float v, int mask, int lane) { return __builtin_bit_cast(float, __builtin_amdgcn_ds_bpermute((lane ^ mask) << 2, __builtin_bit_cast(int, v))); }
__device__ __forceinline__ float fast_sigmoid(float x) { return __builtin_amdgcn_rcpf(1.0f + __builtin_amdgcn_exp2f(-x * LOG2E)); }

#define XB_TMO      128
#define XB_XCNT(j)  (256  + 64 * (j))
#define XB_XSUB(j)  (1280 + 64 * (j))
#define XB_XGEN(j)  (2304 + 64 * (j))
#define XB_TOP      3328
#define XB_TOPGEN   3392
#define XCD_BAR_WORDS 3456
#define XB_SPIN_CAP (1u << 18)
__device__ __forceinline__ unsigned xb_ld(unsigned* p)              { return __hip_atomic_load(p, __ATOMIC_RELAXED, __HIP_MEMORY_SCOPE_AGENT); }
__device__ __forceinline__ unsigned xb_add(unsigned* p, unsigned v) { return __hip_atomic_fetch_add(p, v, __ATOMIC_RELAXED, __HIP_MEMORY_SCOPE_AGENT); }
__device__ __forceinline__ unsigned xb_xcc_id() { return (unsigned)__builtin_amdgcn_s_getreg((3 << 11) | 20) & 0xFu; }
#define XB_SPIN(cond, bar) do { unsigned _sp = 0; while (cond) { __builtin_amdgcn_s_sleep(1); \
    if ((++_sp & 255u) == 0u) { if (xb_ld(&(bar)[XB_TMO])) break; if (_sp > XB_SPIN_CAP) { atomicAdd(&(bar)[XB_TMO], 1u); break; } } } } while (0)
struct XcdBarrier { unsigned* bar; unsigned x; volatile LAS unsigned* st; };
__device__ __forceinline__ XcdBarrier xcd_barrier_post(unsigned* bar, volatile LAS unsigned* st, int tid) {
    XcdBarrier b; b.bar = bar; b.x = xb_xcc_id(); b.st = st;
    if (tid == 0) (void)xb_add(&bar[XB_XCNT(b.x)], 1u);
    return b;
}
__device__ __forceinline__ void xcd_barrier_complete(unsigned* bar, unsigned x, unsigned& nloc, unsigned& nx) {
    const unsigned G = gridDim.x * gridDim.y * gridDim.z;
    unsigned sum, cnt, mine, sp = 0u;
    for (;;) {
        sum = 0u; cnt = 0u; mine = 0u;
#pragma unroll
        for (unsigned j = 0; j < 16; ++j) { const unsigned c = xb_ld(&bar[XB_XCNT(j)]); sum += c; cnt += (c > 0u) ? 1u : 0u; mine = (j == x) ? c : mine; }
        if (sum == G) break;
        __builtin_amdgcn_s_sleep(1);
        if ((++sp & 255u) == 0u) { if (xb_ld(&bar[XB_TMO])) break; if (sp > XB_SPIN_CAP) { atomicAdd(&bar[XB_TMO], 1u); break; } }
    }
    nloc = mine > 0u ? mine : 1u; nx = cnt > 0u ? cnt : 1u;
}
__device__ __forceinline__ void xcd_barrier(const XcdBarrier& b, int tid) {
    asm volatile("s_waitcnt vmcnt(0)" ::: "memory");
    __syncthreads();
    if (tid == 0) {
        unsigned* bar = b.bar;
        __builtin_amdgcn_s_waitcnt(0);
        unsigned nloc = b.st[0], nx = b.st[1];
        if (nloc == 0u) { xcd_barrier_complete(bar, b.x, nloc, nx); b.st[0] = nloc; b.st[1] = nx; }
        const unsigned old = xb_add(&bar[XB_XSUB(b.x)], 1u);
        const unsigned gen = old / nloc;
        if (old + 1u == (gen + 1u) * nloc) {
            __builtin_amdgcn_fence(__ATOMIC_RELEASE, "agent");
            asm volatile("s_waitcnt vmcnt(0)" ::: "memory");
            const unsigned og = xb_add(&bar[XB_TOP], 1u);
            const unsigned tg = og / nx;
            if (og + 1u == (tg + 1u) * nx) xb_add(&bar[XB_TOPGEN], 1u);
            else XB_SPIN(xb_ld(&bar[XB_TOPGEN]) == tg, bar);
            __builtin_amdgcn_fence(__ATOMIC_ACQUIRE, "agent");
            xb_add(&bar[XB_XGEN(b.x)], 1u);
            asm volatile("s_waitcnt vmcnt(0)" ::: "memory");
        } else {
            XB_SPIN(xb_ld(&bar[XB_XGEN(b.x)]) == gen, bar);
            __builtin_amdgcn_fence(__ATOMIC_ACQUIRE, "agent");
            asm volatile("s_waitcnt vmcnt(0)" ::: "memory");
        }
    }
    __syncthreads();
}

namespace pg8 {
constexpr int BM = 256, BK = 64, HALF = 128, HTB = HALF * BK * 2, NXCD = 8, WGM = 8;
__host__ __device__ __forceinline__ int lds_byte(int r, int c) { const int st = (r >> 4) * 2 + (c >> 5), rr = r & 15, cc = c & 31, ob = rr * 64 + cc * 2; return st * 1024 + (ob ^ (((ob >> 9) & 1) << 5)); }
__host__ __device__ __forceinline__ void stage_rc(int b, int& R, int& C) { const int st = b / 1024, sb = b % 1024, swz = sb ^ (((sb >> 9) & 1) << 5); R = (st >> 1) * 16 + swz / 64; C = (st & 1) * 32 + (swz % 64) / 2; }
__host__ __device__ __forceinline__ int perm32(int rho) { const int n = rho >> 4, i = rho & 15; return 8 * (i >> 2) + 4 * n + (i & 3); }

struct Unit { int pm, pn, am, bn, z; };
struct Gemm { const bf16_t* A; const bf16_t* Bt; int K; };

struct OrderStd {
    int nM, nN, nwg, G, c;
    __device__ void init(int M_, int N_, int G_, int c_) { nM = M_ / BM; nN = N_ / BM; nwg = nM * nN; G = G_; c = c_; }
    __device__ bool next(int i, Unit& u) const {
        const long L = (long)i * G + c; if (L >= nwg) return false;
        int wgid = (int)L; { const int q = nwg / NXCD, r = nwg % NXCD, xcd = wgid % NXCD, off = wgid / NXCD; wgid = (xcd < r ? xcd * (q + 1) : r * (q + 1) + (xcd - r) * q) + off; }
        const int nig = WGM * nN, gid = wgid / nig, fm = gid * WGM, gsz = (nM - fm) < WGM ? (nM - fm) : WGM;
        u.pm = fm + ((wgid % nig) % gsz); u.pn = (wgid % nig) / gsz; u.am = u.pm; u.bn = u.pn; u.z = 0; return true;
    }
};
template <int MODE> struct OrderTri {
    OrderStd base;
    __device__ bool next(int i, Unit& u) const {
        if (i >= 3) return false;
        if (!base.next(0, u)) return false;
        u.z = i; u.bn = 4 * i + u.pn; u.am = MODE ? 64 * i + u.pm : u.pm; return true;
    }
};

template <class Epi, class Sched>
__device__ __forceinline__ void gemm_phase(LAS unsigned char* lds, const Gemm g, const Sched& S, const Epi& E, const int tid) {
    const int wid = __builtin_amdgcn_readfirstlane(tid >> 6), lane = tid & 63, wr = wid >> 2, wc = wid & 3, fr = lane & 15, fq = lane >> 4;
    const int K = g.K, nt = K / BK;
    unsigned voffA[2], voffB[2];
#pragma unroll
    for (int i = 0; i < 2; ++i) { int R, C; stage_rc(tid * 16 + i * 8192, R, C); const int Rb = Epi::PERM ? ((R & ~31) + perm32(R & 31)) : R;
        voffA[i] = (unsigned)(R * K + C) * 2u; voffB[i] = (unsigned)(Rb * K + C) * 2u; }
    const size_t kstep = (size_t)(BK * 2);
    const size_t hstep = (size_t)HALF * K * 2;
    const size_t tstep = 2 * hstep;
    const unsigned ldsw = (unsigned)wid * 1024u;
    const int aoff = lds_byte(wr * 64 + fr, fq * 8), boff = lds_byte(wc * 32 + fr, fq * 8);
#define PG8_SA(b, h) (((b) * 2 + (h)) * HTB)
#define PG8_SB(b, h) ((4 + (b) * 2 + (h)) * HTB)
#define PG8_STAGE(bufoff, gbase, voff) do { _Pragma("unroll") for (int _i = 0; _i < 2; ++_i) \
        __builtin_amdgcn_global_load_lds((const unsigned*)((const char*)(gbase) + (voff)[_i]), (LAS unsigned*)(lds + (bufoff) + ldsw + _i * 8192), 16, 0, 0); } while (0)
#define PG8_LDA(dst, b, h) do { _Pragma("unroll") for (int m = 0; m < 4; ++m) _Pragma("unroll") for (int k = 0; k < 2; ++k) dst[m][k] = *(const LAS bf16x8*)(lds + PG8_SA(b, h) + aoff + m * 2048 + k * 1024); } while (0)
#define PG8_LDB(dst, b, h) do { _Pragma("unroll") for (int n = 0; n < 2; ++n) _Pragma("unroll") for (int k = 0; k < 2; ++k) dst[n][k] = *(const LAS bf16x8*)(lds + PG8_SB(b, h) + boff + n * 2048 + k * 1024); } while (0)
#define PG8_MMA(ai, bj, At, Bt) do { __builtin_amdgcn_s_setprio(1); _Pragma("unroll") for (int m = 0; m < 4; ++m) _Pragma("unroll") for (int n = 0; n < 2; ++n) _Pragma("unroll") for (int k = 0; k < 2; ++k) \
        acc[ai][bj][m][n] = __builtin_amdgcn_mfma_f32_16x16x32_bf16(Bt[n][k], At[m][k], acc[ai][bj][m][n], 0, 0, 0); __builtin_amdgcn_s_setprio(0); } while (0)
#define PG8_WAIT_V(n) asm volatile("s_waitcnt vmcnt(" #n ")" ::: "memory")
#define PG8_WAIT_L(n) asm volatile("s_waitcnt lgkmcnt(" #n ")" ::: "memory")
#define PG8_BAR __builtin_amdgcn_s_barrier()
#define PG8_SCHED __builtin_amdgcn_sched_barrier(0)
    Unit cur, nxt; int ui = 0;
    if (!S.next(0, cur)) return;
    f32x4 acc[2][2][4][2];
#pragma unroll
    for (int a = 0; a < 2; ++a)
#pragma unroll
        for (int b = 0; b < 2; ++b)
#pragma unroll
            for (int m = 0; m < 4; ++m)
#pragma unroll
                for (int n = 0; n < 2; ++n) acc[a][b][m][n] = (f32x4){0.f, 0.f, 0.f, 0.f};
    bf16x8 At[4][2], B0[2][2], B1[2][2];
    const char* cA = (const char*)g.A + (size_t)cur.am * tstep; const char* cB = (const char*)g.Bt + (size_t)cur.bn * tstep;
    PG8_STAGE(PG8_SB(0, 0), cB, voffB); PG8_STAGE(PG8_SB(0, 1), cB + hstep, voffB); PG8_STAGE(PG8_SA(0, 0), cA, voffA); PG8_STAGE(PG8_SA(0, 1), cA + hstep, voffA);
    if (wr == 1) PG8_BAR;
    PG8_WAIT_V(2); PG8_BAR;
    PG8_STAGE(PG8_SB(1, 0), cB + kstep, voffB); PG8_STAGE(PG8_SA(1, 0), cA + kstep, voffA); PG8_STAGE(PG8_SB(1, 1), cB + hstep + kstep, voffB);
    PG8_WAIT_V(6); PG8_BAR;
    for (;;) {
        const bool has_next = S.next(ui + 1, nxt);
        const char* nA = has_next ? (const char*)g.A + (size_t)nxt.am * tstep : cA; const char* nB = has_next ? (const char*)g.Bt + (size_t)nxt.bn * tstep : cB;
        for (int t = 0; t < nt; t += 2) {
            const bool last = (t == nt - 2);
            const char* a1 = cA + (size_t)(t + 1) * kstep;
            const char* a2 = last ? nA : cA + (size_t)(t + 2) * kstep; const char* b2 = last ? nB : cB + (size_t)(t + 2) * kstep;
            const char* a3 = a2 + kstep; const char* b3 = b2 + kstep;
            PG8_LDB(B0, 0, 0); PG8_LDB(B1, 0, 1); PG8_SCHED; PG8_LDA(At, 0, 0); PG8_STAGE(PG8_SA(1, 1), a1 + hstep, voffA);
            PG8_WAIT_V(8); PG8_WAIT_L(0); PG8_BAR; PG8_MMA(0, 0, At, B0); PG8_MMA(0, 1, At, B1); PG8_BAR; PG8_SCHED;
            PG8_LDA(At, 0, 1); PG8_STAGE(PG8_SB(0, 0), b2, voffB); PG8_STAGE(PG8_SB(0, 1), b2 + hstep, voffB); PG8_STAGE(PG8_SA(0, 0), a2, voffA);
            PG8_WAIT_V(8); PG8_WAIT_L(0); PG8_BAR; PG8_MMA(1, 0, At, B0); PG8_MMA(1, 1, At, B1); PG8_BAR; PG8_SCHED;
            PG8_LDB(B0, 1, 0); PG8_LDB(B1, 1, 1); PG8_SCHED; PG8_LDA(At, 1, 0); PG8_STAGE(PG8_SA(0, 1), a2 + hstep, voffA);
            PG8_WAIT_V(8); PG8_WAIT_L(0); PG8_BAR; PG8_MMA(0, 0, At, B0); PG8_MMA(0, 1, At, B1); PG8_BAR; PG8_SCHED;
            PG8_LDA(At, 1, 1); PG8_STAGE(PG8_SB(1, 0), b3, voffB); PG8_STAGE(PG8_SB(1, 1), b3 + hstep, voffB); PG8_STAGE(PG8_SA(1, 0), a3, voffA);
            PG8_WAIT_V(8); PG8_WAIT_L(0); PG8_BAR; PG8_MMA(1, 0, At, B0); PG8_MMA(1, 1, At, B1); PG8_BAR; PG8_SCHED;
        }
        if (wr == 0) PG8_BAR;
        { int t2 = tid; asm volatile("" : "+v"(t2)); const int l2 = t2 & 63; E(acc, cur, wr, wc, l2 & 15, l2 >> 4); }
        if (!has_next) break;
        if (!E.keep(cur)) {
#pragma unroll
            for (int a = 0; a < 2; ++a)
#pragma unroll
                for (int b = 0; b < 2; ++b)
#pragma unroll
                    for (int m = 0; m < 4; ++m)
#pragma unroll
                        for (int n = 0; n < 2; ++n) acc[a][b][m][n] = (f32x4){0.f, 0.f, 0.f, 0.f};
        }
        cur = nxt; cA = nA; cB = nB; ++ui;
        if (wr == 1) PG8_BAR;
    }
    PG8_WAIT_V(0);
    PG8_BAR;
#undef PG8_SA
#undef PG8_SB
#undef PG8_STAGE
#undef PG8_LDA
#undef PG8_LDB
#undef PG8_MMA
#undef PG8_WAIT_V
#undef PG8_WAIT_L
#undef PG8_BAR
#undef PG8_SCHED
}

typedef f32x4 Acc[2][2][4][2];
#define PG8_FOR_AI_M _Pragma("unroll") for (int ai = 0; ai < 2; ++ai) _Pragma("unroll") for (int m = 0; m < 4; ++m)

__device__ __forceinline__ u32x4 pack8(const f32x4 v0, const f32x4 v1) { u32x4 w; w.x = cvt_pk_bf16(v0[0], v0[1]); w.y = cvt_pk_bf16(v0[2], v0[3]); w.z = cvt_pk_bf16(v1[0], v1[1]); w.w = cvt_pk_bf16(v1[2], v1[3]); return w; }

struct EpiSwiglu {
    static constexpr bool PERM = true;
    bf16_t* H;
    __device__ __forceinline__ bool keep(const Unit&) const { return false; }
    __device__ __forceinline__ void operator()(Acc& acc, const Unit& u, int wr, int wc, int fr, int fq) const {
        const int row0 = u.pm * BM + wr * 64 + fr, col0 = u.pn * 128 + wc * 32 + 8 * fq;
        PG8_FOR_AI_M { f32x4 v[2];
#pragma unroll
            for (int n = 0; n < 2; ++n)
#pragma unroll
                for (int j = 0; j < 4; ++j) { const float gt = acc[ai][0][m][n][j], up = acc[ai][1][m][n][j]; v[n][j] = gt * fast_sigmoid(gt) * up; }
            *(u32x4*)(H + (size_t)(row0 + ai * HALF + m * 16) * DFF + col0) = pack8(v[0], v[1]); }
    }
};
struct EpiResid {
    static constexpr bool PERM = false;
    const float* base; float* out; float alpha, s;
    __device__ __forceinline__ bool keep(const Unit&) const { return false; }
    __device__ __forceinline__ void operator()(Acc& acc, const Unit& u, int wr, int wc, int fr, int fq) const {
        const int col0 = u.pn * BM + wc * 32 + 4 * fq;
        PG8_FOR_AI_M { const size_t off = (size_t)(u.pm * BM + ai * HALF + wr * 64 + m * 16 + fr) * D + col0;
#pragma unroll
            for (int bj = 0; bj < 2; ++bj)
#pragma unroll
                for (int n = 0; n < 2; ++n) { const f32x4 bs = *(const f32x4*)(base + off + bj * HALF + n * 16); *(f32x4*)(out + off + bj * HALF + n * 16) = bs * alpha + acc[ai][bj][m][n] * s; } }
    }
};
__device__ __forceinline__ void rope32(f32x4 (&v)[2], const float* rope, int pos, int fq, int lane) {
    const float* cs = rope + (size_t)pos * 16 + 8 * (fq & 1); const float* sn = cs + SEQ * 16;
#pragma unroll
    for (int n = 0; n < 2; ++n) { const f32x4 c = *(const f32x4*)(cs + 4 * n), s = *(const f32x4*)(sn + 4 * n);
#pragma unroll
        for (int j = 0; j < 4; ++j) { const float x = v[n][j], p = shx(x, 32, lane); v[n][j] = x * c[j] + ((fq < 2) ? -p : p) * s[j]; } }
}
struct EpiWin {
    static constexpr bool PERM = true;
    bf16_t *CQ, *CKV, *KPE, *MEMQ, *DIL; float *SSQ, *SSKV; const float* rope;
    __device__ __forceinline__ bool keep(const Unit&) const { return false; }
    __device__ __forceinline__ void operator()(Acc& acc, const Unit& u, int wr, int wc, int fr, int fq) const {
        const int row0 = u.pm * BM + wr * 64 + fr, cw = wc * 32 + 8 * fq, pn = u.pn;
        if (pn < 2) {
            bf16_t* O = pn ? CKV : CQ; float* SS = pn ? SSKV : SSQ;
            PG8_FOR_AI_M { const int row = row0 + ai * HALF + m * 16; float s = 0.f;
#pragma unroll
                for (int bj = 0; bj < 2; ++bj) { const f32x4 a = acc[ai][bj][m][0], b = acc[ai][bj][m][1];
                    s += (a[0] * a[0] + a[1] * a[1]) + (a[2] * a[2] + a[3] * a[3]) + (b[0] * b[0] + b[1] * b[1]) + (b[2] * b[2] + b[3] * b[3]);
                    *(u32x4*)(O + (size_t)row * 256 + bj * HALF + cw) = pack8(a, b); }
                s += shx(s, 16, fq * 16 + fr); s += shx(s, 32, fq * 16 + fr);
                if (fq == 0) SS[row * 4 + wc] = s; asm volatile("" ::: "memory"); }
        } else if (pn == 2) {
            if (wc == 0) {
                PG8_FOR_AI_M { const int row = row0 + ai * HALF + m * 16; f32x4 v[2] = {acc[ai][0][m][0], acc[ai][0][m][1]};
                    rope32(v, rope, row, fq, fq * 16 + fr);
                    *(u32x4*)(KPE + (size_t)row * 32 + 8 * fq) = pack8(v[0], v[1]); asm volatile("" ::: "memory"); }
            }
        } else if (pn < 5) {
            PG8_FOR_AI_M { const int row = row0 + ai * HALF + m * 16;
#pragma unroll
                for (int bj = 0; bj < 2; ++bj) *(u32x4*)(MEMQ + (size_t)row * 512 + (pn - 3) * 256 + bj * HALF + cw) = pack8(acc[ai][bj][m][0] * C128, acc[ai][bj][m][1] * C128); }
        } else {
            const float sc = (pn - 5 < 6) ? C128 : 1.0f;
            PG8_FOR_AI_M { const int row = row0 + ai * HALF + m * 16;
#pragma unroll
                for (int bj = 0; bj < 2; ++bj) *(u32x4*)(DIL + (size_t)row * 4608 + (pn - 5) * 256 + bj * HALF + cw) = pack8(acc[ai][bj][m][0] * sc, acc[ai][bj][m][1] * sc); }
        }
    }
};
struct EpiQup {
    static constexpr bool PERM = true;
    bf16_t* Q; const float* SS; const float* rope;
    __device__ __forceinline__ bool keep(const Unit&) const { return false; }
    __device__ __forceinline__ void operator()(Acc& acc, const Unit& u, int wr, int wc, int fr, int fq) const {
        const int row0 = u.pm * BM + wr * 64 + fr, cw = wc * 32 + 8 * fq;
        PG8_FOR_AI_M { const int row = row0 + ai * HALF + m * 16; const f32x4 ss = *(const f32x4*)(SS + row * 4);
            const float rs = C96 / sqrtf(((ss[0] + ss[1]) + (ss[2] + ss[3])) * (1.0f / 256.0f) + LN_EPS);
#pragma unroll
            for (int bj = 0; bj < 2; ++bj) { f32x4 v[2] = {acc[ai][bj][m][0] * rs, acc[ai][bj][m][1] * rs};
                if ((u.pn * 8 + bj * 4 + wc) % 3 == 2) rope32(v, rope, row, fq, fq * 16 + fr);
                *(u32x4*)(Q + (size_t)row * 768 + u.pn * BM + bj * HALF + cw) = pack8(v[0], v[1]); } asm volatile("" ::: "memory"); }
    }
};
struct EpiKVup {
    static constexpr bool PERM = true;
    bf16_t *KN, *V; const float* SS;
    __device__ __forceinline__ bool keep(const Unit&) const { return false; }
    __device__ __forceinline__ void operator()(Acc& acc, const Unit& u, int wr, int wc, int fr, int fq) const {
        const int row0 = u.pm * BM + wr * 64 + fr; bf16_t* O = (wc < 2) ? KN : V; const int cw = (wc & 1) * 32 + 8 * fq;
        PG8_FOR_AI_M { const int row = row0 + ai * HALF + m * 16; const f32x4 ss = *(const f32x4*)(SS + row * 4);
            const float rs = 1.0f / sqrtf(((ss[0] + ss[1]) + (ss[2] + ss[3])) * (1.0f / 256.0f) + LN_EPS);
#pragma unroll
            for (int bj = 0; bj < 2; ++bj) *(u32x4*)(O + (size_t)row * 512 + (u.pn * 2 + bj) * 64 + cw) = pack8(acc[ai][bj][m][0] * rs, acc[ai][bj][m][1] * rs); asm volatile("" ::: "memory"); }
    }
};
struct EpiMemKV {
    static constexpr bool PERM = true;
    bf16_t *MK, *MV;
    __device__ __forceinline__ bool keep(const Unit&) const { return false; }
    __device__ __forceinline__ void operator()(Acc& acc, const Unit& u, int wr, int wc, int fr, int fq) const {
        const int row0 = u.pm * BM + wr * 64 + fr, cw = wc * 32 + 8 * fq; bf16_t* O = (u.pn < 2) ? MK : MV;
        PG8_FOR_AI_M { const int row = row0 + ai * HALF + m * 16;
#pragma unroll
            for (int bj = 0; bj < 2; ++bj) *(u32x4*)(O + (size_t)row * 512 + (u.pn & 1) * BM + bj * HALF + cw) = pack8(acc[ai][bj][m][0], acc[ai][bj][m][1]); }
    }
};
struct EpiGate {
    static constexpr bool PERM = true;
    u32x4* G;
    __device__ __forceinline__ bool keep(const Unit&) const { return false; }
    __device__ __forceinline__ void operator()(Acc& acc, const Unit& u, int wr, int wc, int fr, int fq) const {
        u32x4* g = G + (size_t)u.z * 16 * 512 + ((wr * 4 + wc) * 64 + fq * 16 + fr);
        PG8_FOR_AI_M {
#pragma unroll
            for (int bj = 0; bj < 2; ++bj) { f32x4 v[2];
#pragma unroll
                for (int n = 0; n < 2; ++n)
#pragma unroll
                    for (int j = 0; j < 4; ++j) v[n][j] = fmaxf(fast_sigmoid(acc[ai][bj][m][n][j]), 1e-9f);
                g[((ai * 4 + m) * 2 + bj) * 512] = pack8(v[0], v[1]); } }
    }
};
struct EpiBranch {
    static constexpr bool PERM = true;
    const u32x4* G; bf16_t* MG;
    __device__ __forceinline__ bool keep(const Unit& u) const { return u.z < 2; }
    __device__ __forceinline__ void operator()(Acc& acc, const Unit& u, int wr, int wc, int fr, int fq) const {
        const u32x4* g = G + (size_t)u.z * 16 * 512 + ((wr * 4 + wc) * 64 + fq * 16 + fr);
        const int row0 = u.pm * BM + wr * 64 + fr, cw = u.pn * BM + wc * 32 + 8 * fq;
        PG8_FOR_AI_M {
#pragma unroll
            for (int bj = 0; bj < 2; ++bj) { const int slot = ((ai * 4 + m) * 2 + bj) * 512; const u32x4 a = g[slot];
                float ga[8] = {bf_lo(a.x), bf_hi(a.x), bf_lo(a.y), bf_hi(a.y), bf_lo(a.z), bf_hi(a.z), bf_lo(a.w), bf_hi(a.w)};
                if (u.z < 2) { const u32x4 b = g[slot + 16 * 512];
                    const float gb[8] = {bf_lo(b.x), bf_hi(b.x), bf_lo(b.y), bf_hi(b.y), bf_lo(b.z), bf_hi(b.z), bf_lo(b.w), bf_hi(b.w)};
#pragma unroll
                    for (int e = 0; e < 8; ++e) ga[e] = ga[e] * __builtin_amdgcn_rcpf(gb[e]); }
#pragma unroll
                for (int n = 0; n < 2; ++n)
#pragma unroll
                    for (int j = 0; j < 4; ++j) acc[ai][bj][m][n][j] *= ga[n * 4 + j];
                if (u.z == 2) *(u32x4*)(MG + (size_t)(row0 + ai * HALF + m * 16) * D + bj * HALF + cw) = pack8(acc[ai][bj][m][0], acc[ai][bj][m][1]); } }
    }
};
}

namespace att {
constexpr int NW = 8, QBLK = 32, KVBLK = 64;
constexpr int SHM_K = 64 * 256;
#define SBAR() __builtin_amdgcn_sched_barrier(0)
__device__ __forceinline__ int crow(int r, int hi) { return (r & 3) + 8 * (r >> 2) + 4 * hi; }
struct Params {
    const bf16_t* Q; long ldq;
    const bf16_t* K; long ldk;
    const bf16_t* KP; long ldkp;
    const bf16_t* V; long ldv;
    bf16_t* O; long ldo;
    float* LSE; long ldlse;
    int NT;
    int kbase;
    int i0, L;
    float slope;
};
template <int DV> __device__ __forceinline__ int v_st(int k, int c) { const int kk = (k & ~0xC) | ((k & 4) << 1) | ((k & 8) >> 1); return ((kk >> 3) * (DV / 32) + (c >> 5)) * 512 + ((kk & 7) * 32 + (c & 31)) * 2; }
__device__ __forceinline__ int v_rd_base(int lane) { return ((lane & 3) << 3) | (((lane >> 2) & 3) << 6) | (((lane >> 4) & 1) << 5) | (((lane >> 5) & 1) << 8); }
template <int OFF> __device__ __forceinline__ s16x4 tr_read(int vb) { s16x4 r; asm volatile("ds_read_b64_tr_b16 %0, %1 offset:%2" : "=&v"(r) : "v"(vb), "i"(OFF) : "memory"); return r; }
template <int DV, int D0> __device__ __forceinline__ void pv_one(f32x16& od, int vb, bf16x8 pa0, bf16x8 pa1, bf16x8 pa2, bf16x8 pa3) {
    constexpr int KS = 2 * (DV / 32) * 512, HF = (DV / 32) * 512, B = D0 * 512;
    const s16x4 l0 = tr_read<B + 0 * KS>(vb), h0 = tr_read<B + 0 * KS + HF>(vb), l1 = tr_read<B + 1 * KS>(vb), h1 = tr_read<B + 1 * KS + HF>(vb);
    const s16x4 l2 = tr_read<B + 2 * KS>(vb), h2 = tr_read<B + 2 * KS + HF>(vb), l3 = tr_read<B + 3 * KS>(vb), h3 = tr_read<B + 3 * KS + HF>(vb);
    asm volatile("s_waitcnt lgkmcnt(0)" ::: "memory"); SBAR();
#define ATT_PK(Lo, Hi) (bf16x8){Lo[0], Lo[1], Lo[2], Lo[3], Hi[0], Hi[1], Hi[2], Hi[3]}
    od = __builtin_amdgcn_mfma_f32_32x32x16_bf16(pa0, ATT_PK(l0, h0), od, 0, 0, 0);
    od = __builtin_amdgcn_mfma_f32_32x32x16_bf16(pa1, ATT_PK(l1, h1), od, 0, 0, 0);
    od = __builtin_amdgcn_mfma_f32_32x32x16_bf16(pa2, ATT_PK(l2, h2), od, 0, 0, 0);
    od = __builtin_amdgcn_mfma_f32_32x32x16_bf16(pa3, ATT_PK(l3, h3), od, 0, 0, 0);
#undef ATT_PK
}
template <int DV> __device__ __forceinline__ void pv_all(f32x16* o, int vb, bf16x8 pa0, bf16x8 pa1, bf16x8 pa2, bf16x8 pa3) {
    pv_one<DV, 0>(o[0], vb, pa0, pa1, pa2, pa3); pv_one<DV, 1>(o[1], vb, pa0, pa1, pa2, pa3);
    if constexpr (DV == 128) { pv_one<DV, 2>(o[2], vb, pa0, pa1, pa2, pa3); pv_one<DV, 3>(o[3], vb, pa0, pa1, pa2, pa3); }
}
constexpr float THR2 = 5.0f;
constexpr float NEGBIG = -3.0e38f;
__device__ __forceinline__ void partialSM(f32x16& p0, f32x16& p1, float& m_reg, float& alpha) {
    float pmax = p0[0];
#pragma unroll
    for (int r = 1; r < 16; ++r) pmax = fmaxf(pmax, p0[r]);
#pragma unroll
    for (int r = 0; r < 16; ++r) pmax = fmaxf(pmax, p1[r]);
    { auto rr = __builtin_amdgcn_permlane32_swap(__float_as_uint(pmax), __float_as_uint(pmax), false, false); pmax = fmaxf(__uint_as_float(rr[0]), __uint_as_float(rr[1])); }
    float mn;
    if (__builtin_expect(__all(pmax - m_reg <= THR2), 1)) { mn = m_reg; alpha = 1.f; }
    else { mn = fmaxf(m_reg, pmax); alpha = __builtin_amdgcn_exp2f(m_reg - mn); m_reg = mn; }
#pragma unroll
    for (int r = 0; r < 16; ++r) p0[r] = p0[r] - mn;
#pragma unroll
    for (int r = 0; r < 16; ++r) p1[r] = p1[r] - mn;
#pragma unroll
    for (int r = 0; r < 16; ++r) p0[r] = __builtin_amdgcn_exp2f(p0[r]);
}
__device__ __forceinline__ void finishSM(f32x16& p0, f32x16& p1, float alpha, float& l_reg, bf16x8& pa0, bf16x8& pa1, bf16x8& pa2, bf16x8& pa3) {
#pragma unroll
    for (int r = 0; r < 16; ++r) p1[r] = __builtin_amdgcn_exp2f(p1[r]);
    float ps = 0;
#pragma unroll
    for (int r = 0; r < 16; ++r) ps += p0[r];
#pragma unroll
    for (int r = 0; r < 16; ++r) ps += p1[r];
    { auto rr = __builtin_amdgcn_permlane32_swap(__float_as_uint(ps), __float_as_uint(ps), false, false); ps = __uint_as_float(rr[0]) + __uint_as_float(rr[1]); }
    l_reg = l_reg * alpha + ps;
#define ATT_PK4(P, BASE, OUT) do { unsigned a0 = cvt_pk_bf16(P[BASE + 0], P[BASE + 1]), a1 = cvt_pk_bf16(P[BASE + 2], P[BASE + 3]);   \
    unsigned b0 = cvt_pk_bf16(P[BASE + 4], P[BASE + 5]), b1 = cvt_pk_bf16(P[BASE + 6], P[BASE + 7]);                              \
    auto r0 = __builtin_amdgcn_permlane32_swap(a0, b0, false, false); auto r1 = __builtin_amdgcn_permlane32_swap(a1, b1, false, false); \
    u32x4 w = {r0[0], r1[0], r0[1], r1[1]}; OUT = __builtin_bit_cast(bf16x8, w); } while (0)
    ATT_PK4(p0, 0, pa0); ATT_PK4(p0, 8, pa1); ATT_PK4(p1, 0, pa2); ATT_PK4(p1, 8, pa3);
#undef ATT_PK4
}
template <int DQK> __device__ __forceinline__ void qkt(f32x16& p0, f32x16& p1, const char* Ks, const bf16x8* qr, int r32, int hi) {
    p0 = f32x16{}; p1 = f32x16{};
#pragma unroll
    for (int d0 = 0; d0 < DQK / 16; ++d0) { const int ch = d0 * 2 + hi;
        const bf16x8 b0 = *reinterpret_cast<const bf16x8*>(Ks + r32 * 256 + ((ch ^ (r32 & 7)) << 4));
        const bf16x8 b1 = *reinterpret_cast<const bf16x8*>(Ks + (32 + r32) * 256 + ((ch ^ (r32 & 7)) << 4));
        p0 = __builtin_amdgcn_mfma_f32_32x32x16_bf16(b0, qr[d0], p0, 0, 0, 0);
        p1 = __builtin_amdgcn_mfma_f32_32x32x16_bf16(b1, qr[d0], p1, 0, 0, 0); }
}
__device__ __forceinline__ void dil_mask(f32x16& p0, f32x16& p1, int base, int rlo, int rhi, float slope) {
    asm volatile("" : "+v"(base));
#pragma unroll
    for (int r = 0; r < 16; ++r) { const int rel = base + (r & 3) + 8 * (r >> 2), rel1 = rel + 32;
        p0[r] = (rel >= rlo && rel <= rhi) ? p0[r] - slope * fabsf((float)rel) : NEGBIG;
        p1[r] = (rel1 >= rlo && rel1 <= rhi) ? p1[r] - slope * fabsf((float)rel1) : NEGBIG; }
}

template <int DQK, int DV, int MODE>
__device__ __forceinline__ void attn_unit(const Params& P, char* lds, const int tid) {
    constexpr int SHM_V = KVBLK * DV * 2;
    constexpr int NKL = (DQK == 128) ? 2 : 2, NVL = (DV == 128) ? 2 : 1;
    const int wid = tid >> 6, lane = tid & 63, r32 = lane & 31, hi = lane >> 5;
    char* V_lds = lds; char* K_lds = lds + 2 * SHM_V;
    float* ws = (float*)(lds + 2 * SHM_V + 2 * SHM_K) + wid * 64; float* li_l = ws; float* al_l = ws + 32;
    float m_reg = -1e30f, l_reg = 0; f32x16 o[DV / 32]; bf16x8 qr[DQK / 16];
#pragma unroll
    for (int d = 0; d < DV / 32; ++d) o[d] = f32x16{};
    { const bf16_t* Qw = P.Q + (long)(wid * QBLK + r32) * P.ldq + hi * 8;
#pragma unroll
      for (int d0 = 0; d0 < DQK / 16; ++d0) qr[d0] = *reinterpret_cast<const bf16x8*>(Qw + d0 * 16); }
    int krow[NKL], kch[NKL], vrow[NVL], vch[NVL];
    if constexpr (DQK == 128) { krow[0] = tid >> 4; krow[1] = 32 + (tid >> 4); kch[0] = kch[1] = tid & 15; }
    else { krow[0] = tid >> 3; kch[0] = tid & 7; krow[1] = (tid >> 2) & 63; kch[1] = 8 + (tid & 3); }
    if constexpr (DV == 128) { vrow[0] = tid >> 4; vrow[1] = 32 + (tid >> 4); vch[0] = vch[1] = tid & 15; }
    else { vrow[0] = tid >> 3; vch[0] = tid & 7; }
    const bool kpe_on = (MODE != 0) || (tid < 256);
    const int vb0 = (int)(uintptr_t)V_lds + v_rd_base(lane);
    constexpr int SD = (MODE == 2) ? 1 : 2, SE = 0, SO = SD - 1;
    struct Slot { bf16x8 k[NKL]; bf16x8 v[NVL]; } sr_[SD];
    auto keyrow = [&](int t, int row) -> long { long kr = (long)t * KVBLK + row; if constexpr (MODE == 2) { kr += P.kbase; kr = kr < 0 ? 0 : (kr >= P.L ? P.L - 1 : kr); } return kr; };
#define ATT_SLOAD(i, t) do { \
    if constexpr (MODE == 0) { sr_[i].k[0] = *reinterpret_cast<const bf16x8*>(P.K + keyrow(t, krow[0]) * P.ldk + kch[0] * 8); \
        if (kpe_on) sr_[i].k[1] = *reinterpret_cast<const bf16x8*>(P.KP + keyrow(t, krow[1]) * P.ldkp + (kch[1] - 8) * 8); } \
    else { _Pragma("unroll") for (int q_ = 0; q_ < NKL; ++q_) sr_[i].k[q_] = *reinterpret_cast<const bf16x8*>(P.K + keyrow(t, krow[q_]) * P.ldk + kch[q_] * 8); } \
    _Pragma("unroll") for (int q_ = 0; q_ < NVL; ++q_) sr_[i].v[q_] = *reinterpret_cast<const bf16x8*>(P.V + keyrow(t, vrow[q_]) * P.ldv + vch[q_] * 8); } while (0)
#define ATT_SWRITE(b, i) do { \
    _Pragma("unroll") for (int q_ = 0; q_ < NVL; ++q_) *(bf16x8*)(V_lds + (b) * SHM_V + v_st<DV>(vrow[q_], vch[q_] * 8)) = sr_[i].v[q_]; \
    *(bf16x8*)(K_lds + (b) * SHM_K + krow[0] * 256 + ((kch[0] ^ (krow[0] & 7)) << 4)) = sr_[i].k[0]; \
    if (kpe_on) *(bf16x8*)(K_lds + (b) * SHM_K + krow[1] * 256 + ((kch[1] ^ (krow[1] & 7)) << 4)) = sr_[i].k[1]; } while (0)
#define ATT_RESC(a) do { if (__any((a) < 1.f)) { if (hi == 0) al_l[r32] = (a); asm volatile("s_waitcnt lgkmcnt(0)" ::: "memory"); \
    _Pragma("unroll") for (int d = 0; d < DV / 32; ++d) _Pragma("unroll") for (int r = 0; r < 16; ++r) o[d][r] *= al_l[crow(r, hi)]; } } while (0)
#define ATT_MASK(p0, p1, t) do { if constexpr (MODE == 2) dil_mask(p0, p1, P.kbase + (t) * KVBLK + 4 * hi - iq, rlo, rhi, P.slope); } while (0)
    const int iq = P.i0 + wid * QBLK + r32; const int rlo = (-iq > -64) ? -iq : -64, rhi = (P.L - 1 - iq < 64) ? P.L - 1 - iq : 64;
    f32x16 pA0, pA1, pB0, pB1; float alA, alB; bf16x8 pa0, pa1, pa2, pa3; const int NT = P.NT;
    ATT_SLOAD(SE, 0); asm volatile("s_waitcnt vmcnt(0)" ::: "memory"); ATT_SWRITE(0, SE); __syncthreads();
    qkt<DQK>(pA0, pA1, K_lds, qr, r32, hi); ATT_MASK(pA0, pA1, 0); partialSM(pA0, pA1, m_reg, alA);
    ATT_SLOAD(SO, 1); if constexpr (SD == 2) { if (2 < NT) ATT_SLOAD(SE, 2); }
    ATT_SWRITE(1, SO); __syncthreads();
    for (int j = 1; j + 1 < NT; j += 2) {
        SBAR(); qkt<DQK>(pB0, pB1, K_lds + SHM_K, qr, r32, hi); ATT_MASK(pB0, pB1, j);
        finishSM(pA0, pA1, alA, l_reg, pa0, pa1, pa2, pa3); SBAR();
        ATT_SLOAD(SO, j + SD); SBAR();
        pv_all<DV>(o, vb0, pa0, pa1, pa2, pa3); partialSM(pB0, pB1, m_reg, alB);
        __syncthreads(); ATT_SWRITE(0, SE);
        ATT_RESC(alB); __syncthreads();
        SBAR(); qkt<DQK>(pA0, pA1, K_lds, qr, r32, hi); ATT_MASK(pA0, pA1, j + 1);
        finishSM(pB0, pB1, alB, l_reg, pa0, pa1, pa2, pa3); SBAR();
        if (SD == 1 || j + 3 < NT) ATT_SLOAD(SE, j + 1 + SD); SBAR();
        pv_all<DV>(o, vb0 + SHM_V, pa0, pa1, pa2, pa3); partialSM(pA0, pA1, m_reg, alA);
        __syncthreads(); ATT_SWRITE(1, SO);
        ATT_RESC(alA); __syncthreads();
    }
    SBAR(); qkt<DQK>(pB0, pB1, K_lds + SHM_K, qr, r32, hi); ATT_MASK(pB0, pB1, NT - 1);
    finishSM(pA0, pA1, alA, l_reg, pa0, pa1, pa2, pa3); SBAR();
    pv_all<DV>(o, vb0, pa0, pa1, pa2, pa3); partialSM(pB0, pB1, m_reg, alB);
    __syncthreads(); ATT_RESC(alB);
    finishSM(pB0, pB1, alB, l_reg, pa0, pa1, pa2, pa3); SBAR();
    pv_all<DV>(o, vb0 + SHM_V, pa0, pa1, pa2, pa3);
    if (hi == 0) li_l[r32] = l_reg; asm volatile("s_waitcnt lgkmcnt(0)" ::: "memory");
    if constexpr (MODE == 2) { if (hi == 0) P.LSE[(long)(wid * QBLK + r32) * P.ldlse] = m_reg + __builtin_amdgcn_logf(l_reg); }
    float rli[16];
#pragma unroll
    for (int r = 0; r < 16; ++r) rli[r] = __builtin_amdgcn_rcpf(li_l[crow(r, hi)]);
    bf16_t* Ow = P.O + (long)(wid * QBLK) * P.ldo;
#pragma unroll
    for (int r = 0; r < 16; ++r) { const int orow = crow(r, hi);
#pragma unroll
        for (int d0 = 0; d0 < DV / 32; ++d0) Ow[(long)orow * P.ldo + d0 * 32 + r32] = (bf16_t)f2bf(o[d0][r] * rli[r]); }
    __syncthreads();
#undef ATT_SLOAD
#undef ATT_SWRITE
#undef ATT_RESC
#undef ATT_MASK
}
#undef SBAR
}

constexpr int NWAVES = 8;
constexpr int NPHASES = 18;
enum { P_PRO = 0, P_F1A, P_F1B, P_LN1, P_WIN0, P_UP0, P_ATT0, P_CMB0, P_WIN1, P_UP1, P_ATT1, P_CMB1, P_BR, P_WO, P_LN2, P_F2A, P_F2B, P_LN3 };
constexpr int CW_BAR = 4096;

struct Args { const float* in[24]; float* out; unsigned char* ws; int ph_lo, ph_hi; };
enum { I_X = 0, I_MEM, I_WIN, I_QN, I_KVN, I_WUQ, I_WUKV, I_WMKV, I_WBRA, I_WBRB, I_WBRC, I_WO, I_F1G, I_F1U, I_F1D, I_F2G, I_F2U, I_F2D, I_LN1G, I_LN1B, I_LN2G, I_LN2B, I_LN3G, I_LN3B };

__device__ __forceinline__ float wave_sum(float v, int lane) {
#pragma unroll
    for (int o = 1; o < 64; o <<= 1) v += shx(v, o, lane);
    return v;
}
template <int IL>
__device__ __forceinline__ void transpose_weight(const float* W, int K, int ldw, int col0, int nnb, bf16_t* WT, int drow0, const float* scale, LAS float* scr, int lane, int gw, int NGW, int& off) {
    const int nitems = (K / 64) * nnb;
    for (int it = (gw + NGW - off % NGW) % NGW; it < nitems; it += NGW) {
        const int kb = it / nnb, nb = it % nnb, k0 = 64 * kb, n0 = col0 + 32 * nb;
        const int dr = IL ? drow0 + (nb >> 2) * 256 + (nb & 3) * 32 : drow0 + 32 * nb;
#pragma unroll 8
        for (int i = 0; i < 32; ++i) { const int kk = 2 * i + (lane >> 5); float v = W[(size_t)(k0 + kk) * ldw + n0 + (lane & 31)]; if (scale) v *= scale[k0 + kk]; scr[kk * 33 + (lane & 31)] = v; }
        asm volatile("s_waitcnt lgkmcnt(0)" ::: "memory");
        const int c = lane & 7;
#pragma unroll
        for (int j = 0; j < 4; ++j) { const int n = (lane >> 3) + 8 * j; const LAS float* s = scr + (8 * c) * 33 + n;
            u32x4 o; o.x = pk2(s[0 * 33], s[1 * 33]); o.y = pk2(s[2 * 33], s[3 * 33]); o.z = pk2(s[4 * 33], s[5 * 33]); o.w = pk2(s[6 * 33], s[7 * 33]);
            *(u32x4*)(WT + (size_t)(dr + n) * K + k0 + 8 * c) = o; }
        asm volatile("s_waitcnt lgkmcnt(0)" ::: "memory");
    }
    off += nitems;
}
__device__ __forceinline__ void cvt_rows(const float* a, bf16_t* o, long n8, long gt, long NGT) {
    for (long i = gt; i < n8; i += NGT) { const f32x4 x = *(const f32x4*)(a + i * 8), y = *(const f32x4*)(a + i * 8 + 4);
        u32x4 w; w.x = pk2(x[0], x[1]); w.y = pk2(x[2], x[3]); w.z = pk2(y[0], y[1]); w.w = pk2(y[2], y[3]); *(u32x4*)(o + i * 8) = w; }
}
__device__ __forceinline__ void sincos_d(double a, float& s, float& c) {
    const double k = rint(a * 0.63661977236758134308);
    double r = fma(-k, 1.57079632679489655800, a); r = fma(-k, 6.12323399573676603587e-17, r);
    const double r2 = r * r;
    double sp = -7.6471637318198164759e-13; sp = fma(sp, r2, 1.6059043836821614599e-10); sp = fma(sp, r2, -2.5052108385441718775e-8); sp = fma(sp, r2, 2.7557319223985890653e-6);
    sp = fma(sp, r2, -1.9841269841269841270e-4); sp = fma(sp, r2, 8.3333333333333333333e-3); sp = fma(sp, r2, -1.6666666666666666667e-1); const double sv = fma(sp * r2, r, r);
    double cp = 4.7794773323873852974e-14; cp = fma(cp, r2, -1.1470745597729724714e-11); cp = fma(cp, r2, 2.0876756987868098979e-9); cp = fma(cp, r2, -2.7557319223985890653e-7);
    cp = fma(cp, r2, 2.4801587301587301587e-5); cp = fma(cp, r2, -1.3888888888888888889e-3); cp = fma(cp, r2, 4.1666666666666666667e-2); cp = fma(cp, r2, -0.5); const double cv = fma(cp, r2, 1.0);
    const int q = ((int)k) & 3;
    const double ss = (q & 1) ? cv : sv, cc = (q & 1) ? sv : cv;
    s = (float)((q & 2) ? -ss : ss); c = (float)(((q + 1) & 2) ? -cc : cc);
}
__device__ __forceinline__ void ln_rows(float* z, bf16_t* ob, const float* g, const float* b, int lane, int gw, int NGW) {
    f32x4 gv[4], bv[4];
#pragma unroll
    for (int j = 0; j < 4; ++j) { gv[j] = *((const f32x4*)g + lane + 64 * j); bv[j] = *((const f32x4*)b + lane + 64 * j); }
    for (int m = gw; m < M; m += NGW) {
        f32x4* xr = (f32x4*)(z + (size_t)m * D) + lane;
        f32x4 v[4]; float s = 0.f;
#pragma unroll
        for (int j = 0; j < 4; ++j) { v[j] = xr[64 * j]; s += (v[j].x + v[j].y) + (v[j].z + v[j].w); }
        const float mean = wave_sum(s, lane) * (1.f / D); float s2 = 0.f;
#pragma unroll
        for (int j = 0; j < 4; ++j) { v[j] = v[j] - mean; s2 += (v[j].x * v[j].x + v[j].y * v[j].y) + (v[j].z * v[j].z + v[j].w * v[j].w); }
        const float rstd = 1.f / sqrtf(wave_sum(s2, lane) * (1.f / D) + LN_EPS);
#pragma unroll
        for (int j = 0; j < 4; ++j) { v[j] = v[j] * rstd * gv[j] + bv[j]; xr[64 * j] = v[j]; }
        if (ob) { u32x2* o8 = (u32x2*)(ob + (size_t)m * D) + lane;
#pragma unroll
            for (int j = 0; j < 4; ++j) { u32x2 w; w.x = pk2(v[j].x, v[j].y); w.y = pk2(v[j].z, v[j].w); o8[64 * j] = w; } }
    }
}

__global__ void __launch_bounds__(NWAVES * 64, 2) mega_fwd(Args args) {
    extern __shared__ __attribute__((aligned(16))) unsigned char lds[];
    LAS unsigned char* ldsp = (LAS unsigned char*)lds;
    volatile LAS unsigned* MISC = (volatile LAS unsigned*)(ldsp + MISC_OFF);
    int tl = threadIdx.x;
    const int wave = __builtin_amdgcn_readfirstlane(tl >> 6);
    const int G = gridDim.x, bx = blockIdx.x;
    const int vcu = (G % 8 == 0) ? (bx % 8) * (G / 8) + bx / 8 : bx;
    unsigned char* ws = args.ws;
    unsigned* ctl = (unsigned*)(ws + WS_CTL);
    for (int u = tl; u < (LDS_BYTES - RING_BYTES) / 4; u += NWAVES * 64) ((LAS unsigned*)(ldsp + RING_BYTES))[u] = 0u;
    __syncthreads();
    XcdBarrier bar; bar.bar = ctl + CW_BAR; bar.x = 0; bar.st = nullptr;
    if (!MK_PER_PHASE) bar = xcd_barrier_post(ctl + CW_BAR, MISC + 8, tl);
    const int lo = args.ph_lo, hi = args.ph_hi;
#define LAUNDER() asm volatile("" : "+v"(tl))
#define IN(k) ((((MK_PHASE_MASK) >> ((k) < 32 ? (k) : 0)) & 1u) && lo <= (k) && (k) < hi)
#define SEAM(k) do { if (IN(k) && IN((k) + 1)) { LAUNDER(); xcd_barrier(bar, tl); } } while (0)
    const int gw = vcu * NWAVES + wave, NGW = G * NWAVES;
    const long NGT = (long)G * NWAVES * 64;
#define GT() ((long)vcu * (NWAVES * 64) + tl)
#define LANE() (tl & 63)

    float* out = args.out;
    bf16_t* AB = (bf16_t*)(ws + WS_AB); bf16_t* HB = (bf16_t*)(ws + WS_H);
    bf16_t* WGU = (bf16_t*)(ws + WS_WGU); bf16_t* WD = (bf16_t*)(ws + WS_WD);
    bf16_t* WIN = (bf16_t*)(ws + WS_WIN); bf16_t* WING = (bf16_t*)(ws + WS_WING);
    bf16_t* WUQ = (bf16_t*)(ws + WS_WUQ); bf16_t* WUKV = (bf16_t*)(ws + WS_WUKV); bf16_t* WMKV = (bf16_t*)(ws + WS_WMKV);
    bf16_t* WBR = (bf16_t*)(ws + WS_WBR); bf16_t* WOt = (bf16_t*)(ws + WS_WO);
    bf16_t* MEMB = (bf16_t*)(ws + WS_MEMB); bf16_t* MEMK = (bf16_t*)(ws + WS_MEMK); bf16_t* MEMV = (bf16_t*)(ws + WS_MEMV);
    float* ROPE = (float*)(ws + WS_ROPE); float* SSQ = (float*)(ws + WS_SSQ); float* SSKV = (float*)(ws + WS_SSKV); float* LSE = (float*)(ws + WS_LSE);
    bf16_t* DIL = (bf16_t*)(ws + WS_DIL); bf16_t* QB = (bf16_t*)(ws + WS_Q); bf16_t* KN = (bf16_t*)(ws + WS_KN); bf16_t* VB = (bf16_t*)(ws + WS_V);
    bf16_t* CQ = (bf16_t*)(ws + WS_CQ); bf16_t* CKV = (bf16_t*)(ws + WS_CKV); bf16_t* KPE = (bf16_t*)(ws + WS_KPE);
    bf16_t* OCAT = (bf16_t*)(ws + WS_OCAT); bf16_t* MLAO = OCAT; bf16_t* DILO = OCAT + (size_t)M * 512; bf16_t* MEMQ = OCAT + (size_t)2 * M * 512;
    bf16_t* MERGED = (bf16_t*)(ws + WS_MERGED);
    LAS float* scr = (LAS float*)(ldsp + wave * 16384);

    if (IN(P_PRO)) {
        LAUNDER(); const int lane = LANE(); const long gt = GT();
        int off = 0;
        transpose_weight<1>(args.in[I_F1G], D, DFF, 0, DFF / 32, WGU, 0, nullptr, scr, lane, gw, NGW, off);
        transpose_weight<1>(args.in[I_F1U], D, DFF, 0, DFF / 32, WGU, 128, nullptr, scr, lane, gw, NGW, off);
        transpose_weight<0>(args.in[I_F1D], DFF, D, 0, D / 32, WD, 0, nullptr, scr, lane, gw, NGW, off);
        transpose_weight<0>(args.in[I_WIN], D, IN_COLS, 0, 16, WIN, 0, nullptr, scr, lane, gw, NGW, off);
        transpose_weight<0>(args.in[I_WIN], D, IN_COLS, 512, 1, WIN, 512, nullptr, scr, lane, gw, NGW, off);
        transpose_weight<0>(args.in[I_WIN], D, IN_COLS, 544, 144, WIN, 1280, nullptr, scr, lane, gw, NGW, off);
        transpose_weight<0>(args.in[I_WIN], D, IN_COLS, 5152, 16, WIN, 768, nullptr, scr, lane, gw, NGW, off);
        transpose_weight<0>(args.in[I_WIN], D, IN_COLS, 5664, 96, WING, 0, nullptr, scr, lane, gw, NGW, off);
        transpose_weight<0>(args.in[I_WUQ], 256, 768, 0, 24, WUQ, 0, args.in[I_QN], scr, lane, gw, NGW, off);
        transpose_weight<0>(args.in[I_WUKV], 256, 1024, 0, 32, WUKV, 0, args.in[I_KVN], scr, lane, gw, NGW, off);
        transpose_weight<0>(args.in[I_WMKV], D, 1024, 0, 32, WMKV, 0, nullptr, scr, lane, gw, NGW, off);
        transpose_weight<0>(args.in[I_WBRA], 512, D, 0, 32, WBR, 0, nullptr, scr, lane, gw, NGW, off);
        transpose_weight<0>(args.in[I_WBRB], 512, D, 0, 32, WBR, 1024, nullptr, scr, lane, gw, NGW, off);
        transpose_weight<0>(args.in[I_WBRC], 512, D, 0, 32, WBR, 2048, nullptr, scr, lane, gw, NGW, off);
        transpose_weight<0>(args.in[I_WO], D, D, 0, 32, WOt, 0, nullptr, scr, lane, gw, NGW, off);
        for (long i = gt; i < 224 * 128; i += NGT) *(u32x4*)(WIN + (size_t)544 * D + i * 8) = (u32x4){0u, 0u, 0u, 0u};
        cvt_rows(args.in[I_X], AB, (long)M * D / 8, gt, NGT);
        cvt_rows(args.in[I_MEM], MEMB, 512L * D / 8, gt, NGT);
        for (long i = gt; i < SEQ * 16; i += NGT) { const int pos = (int)(i >> 4), k = (int)(i & 15);
            const double inv = exp2(-(double)k * (13.287712379549449 / 16.0));
            float s, c; sincos_d((double)pos * inv, s, c); ROPE[i] = c; ROPE[SEQ * 16 + i] = s; }
    }
    SEAM(P_PRO);
    if (IN(P_F1A)) { pg8::Gemm g{AB, WGU, D}; pg8::OrderStd S; S.init(M, 2 * DFF, G, bx); pg8::EpiSwiglu E{HB}; LAUNDER(); pg8::gemm_phase(ldsp, g, S, E, tl); }
    SEAM(P_F1A);
    if (IN(P_F1B)) { pg8::Gemm g{HB, WD, DFF}; pg8::OrderStd S; S.init(M, D, G, bx); pg8::EpiResid E{args.in[I_X], out, ALPHA, 0.5f}; LAUNDER(); pg8::gemm_phase(ldsp, g, S, E, tl); }
    SEAM(P_F1B);
    if (IN(P_LN1)) {
        LAUNDER(); const int lane = LANE();
        ln_rows(out, AB, args.in[I_LN1G], args.in[I_LN1B], lane, gw, NGW);
        int off = 0;
        transpose_weight<1>(args.in[I_F2G], D, DFF, 0, DFF / 32, WGU, 0, nullptr, scr, lane, gw, NGW, off);
        transpose_weight<1>(args.in[I_F2U], D, DFF, 0, DFF / 32, WGU, 128, nullptr, scr, lane, gw, NGW, off);
        transpose_weight<0>(args.in[I_F2D], DFF, D, 0, D / 32, WD, 0, nullptr, scr, lane, gw, NGW, off);
    }
    SEAM(P_LN1);
#pragma unroll 1
    for (int b = 0; b < BATCH; ++b) {
        const int PB = P_WIN0 + 4 * b;
        LAUNDER();
        if (IN(PB)) {
            { pg8::Gemm g{AB + (size_t)b * SEQ * D, WIN, D}; pg8::OrderStd S; S.init(SEQ, NWIN, G, bx);
              pg8::EpiWin E{CQ, CKV, KPE, MEMQ + (size_t)b * SEQ * 512, DIL, SSQ, SSKV, ROPE}; LAUNDER(); pg8::gemm_phase(ldsp, g, S, E, tl); }
            if (b == 0) { pg8::Gemm g{MEMB, WMKV, D}; pg8::OrderStd S; S.init(512, 1024, G, (bx + G - (G >= 232 ? 224 : 0)) % G); pg8::EpiMemKV E{MEMK, MEMV}; LAUNDER(); pg8::gemm_phase(ldsp, g, S, E, tl); }
        }
        SEAM(PB);
        if (IN(PB + 1)) {
            { pg8::Gemm g{CQ, WUQ, 256}; pg8::OrderStd S; S.init(SEQ, 768, G, bx); pg8::EpiQup E{QB, SSQ, ROPE}; LAUNDER(); pg8::gemm_phase(ldsp, g, S, E, tl); }
            { pg8::Gemm g{CKV, WUKV, 256}; pg8::OrderStd S; S.init(SEQ, 1024, G, (bx + G - (G >= 224 ? 96 : 0)) % G); pg8::EpiKVup E{KN, VB, SSKV}; LAUNDER(); pg8::gemm_phase(ldsp, g, S, E, tl); }
        }
        SEAM(PB + 1);
        if (IN(PB + 2)) {
            for (int uid = vcu; uid < 768; uid += G) {
                att::Params P{};
                if (uid < 256) { if (!(MK_ATT_MASK & 1)) continue; const int h = uid >> 5, qb = uid & 31;
                    P.Q = QB + (size_t)qb * 256 * 768 + h * 96; P.ldq = 768; P.K = KN + h * 64; P.ldk = 512; P.KP = KPE; P.ldkp = 32; P.V = VB + h * 64; P.ldv = 512;
                    P.O = MLAO + ((size_t)b * SEQ + qb * 256) * 512 + h * 64; P.ldo = 512; P.NT = SEQ / 64;
                    LAUNDER(); att::attn_unit<96, 64, 0>(P, (char*)lds, tl);
                } else if (uid < 640) { if (!(MK_ATT_MASK & 2)) continue; const int id = uid - 256, g = id >> 7, h = (id >> 5) & 3, x = id & 31;
                    const int dl = (g == 0) ? 1 : (g == 1 ? 4 : 16), nb = 32 / dl, res = x / nb, blk = x % nb, gh = g * 4 + h;
                    const bf16_t* base = DIL + (size_t)res * 4608 + gh * 128; const long ld = 4608L * dl;
                    P.Q = base + (size_t)blk * 256 * ld; P.ldq = ld; P.K = base + 1536; P.ldk = ld; P.V = base + 3072; P.ldv = ld;
                    P.O = (bf16_t*)P.Q; P.ldo = ld; P.LSE = LSE + ((size_t)res + (size_t)blk * 256 * dl) * 12 + gh; P.ldlse = 12L * dl;
                    P.NT = 6; P.i0 = blk * 256; P.kbase = blk * 256 - 64; P.L = SEQ / dl;
                    P.slope = exp2f(-8.0f * (float)(gh + 1) / 12.0f) * (float)dl * LOG2E;
                    LAUNDER(); att::attn_unit<128, 128, 2>(P, (char*)lds, tl);
                } else { if (!(MK_ATT_MASK & 4)) continue; const int id = uid - 640, h = id >> 5, qb = id & 31;
                    bf16_t* q = MEMQ + ((size_t)b * SEQ + qb * 256) * 512 + h * 128;
                    P.Q = q; P.ldq = 512; P.K = MEMK + (size_t)b * 256 * 512 + h * 128; P.ldk = 512; P.V = MEMV + (size_t)b * 256 * 512 + h * 128; P.ldv = 512;
                    P.O = q; P.ldo = 512; P.NT = 4;
                    LAUNDER(); att::attn_unit<128, 128, 1>(P, (char*)lds, tl);
                }
            }
        }
        SEAM(PB + 2);
        if (IN(PB + 3)) {
            LAUNDER(); const int lane = LANE();
            for (int t = gw; t < SEQ; t += NGW) {
                const int h = lane >> 4, d8 = (lane & 15) * 8; const float* ls = LSE + (size_t)t * 12 + h;
                const float l0 = ls[0], l1 = ls[4], l2 = ls[8], mx = fmaxf(l0, fmaxf(l1, l2));
                float w0 = __builtin_amdgcn_exp2f(l0 - mx), w1 = __builtin_amdgcn_exp2f(l1 - mx), w2 = __builtin_amdgcn_exp2f(l2 - mx);
                const float inv = 1.0f / (w0 + w1 + w2); w0 *= inv; w1 *= inv; w2 *= inv;
                const bf16_t* src = DIL + (size_t)t * 4608 + h * 128 + d8;
                const u32x4 a = *(const u32x4*)src, bq = *(const u32x4*)(src + 512), c = *(const u32x4*)(src + 1024);
                u32x4 o;
                o.x = pk2(w0 * bf_lo(a.x) + w1 * bf_lo(bq.x) + w2 * bf_lo(c.x), w0 * bf_hi(a.x) + w1 * bf_hi(bq.x) + w2 * bf_hi(c.x));
                o.y = pk2(w0 * bf_lo(a.y) + w1 * bf_lo(bq.y) + w2 * bf_lo(c.y), w0 * bf_hi(a.y) + w1 * bf_hi(bq.y) + w2 * bf_hi(c.y));
                o.z = pk2(w0 * bf_lo(a.z) + w1 * bf_lo(bq.z) + w2 * bf_lo(c.z), w0 * bf_hi(a.z) + w1 * bf_hi(bq.z) + w2 * bf_hi(c.z));
                o.w = pk2(w0 * bf_lo(a.w) + w1 * bf_lo(bq.w) + w2 * bf_lo(c.w), w0 * bf_hi(a.w) + w1 * bf_hi(bq.w) + w2 * bf_hi(c.w));
                *(u32x4*)(DILO + ((size_t)b * SEQ + t) * 512 + h * 128 + d8) = o;
            }
        }
        SEAM(PB + 3);
    }
    if (IN(P_BR)) {
        u32x4* GT = (u32x4*)(ws + WS_GATES) + (size_t)bx * 3 * 16 * 512;
        { pg8::Gemm g{AB, WING, D}; pg8::OrderTri<0> S; S.base.init(M, D, G, bx); pg8::EpiGate E{GT}; LAUNDER(); pg8::gemm_phase(ldsp, g, S, E, tl); }
        { pg8::Gemm g{OCAT, WBR, 512}; pg8::OrderTri<1> S; S.base.init(M, D, G, bx); pg8::EpiBranch E{GT, MERGED}; LAUNDER(); pg8::gemm_phase(ldsp, g, S, E, tl); }
    }
    SEAM(P_BR);
    if (IN(P_WO)) { pg8::Gemm g{MERGED, WOt, D}; pg8::OrderStd S; S.init(M, D, G, bx); pg8::EpiResid E{out, out, ALPHA, 1.0f}; LAUNDER(); pg8::gemm_phase(ldsp, g, S, E, tl); }
    SEAM(P_WO);
    if (IN(P_LN2)) { LAUNDER(); ln_rows(out, AB, args.in[I_LN2G], args.in[I_LN2B], LANE(), gw, NGW); }
    SEAM(P_LN2);
    if (IN(P_F2A)) { pg8::Gemm g{AB, WGU, D}; pg8::OrderStd S; S.init(M, 2 * DFF, G, bx); pg8::EpiSwiglu E{HB}; LAUNDER(); pg8::gemm_phase(ldsp, g, S, E, tl); }
    SEAM(P_F2A);
    if (IN(P_F2B)) { pg8::Gemm g{HB, WD, DFF}; pg8::OrderStd S; S.init(M, D, G, bx); pg8::EpiResid E{out, out, ALPHA, 0.5f}; LAUNDER(); pg8::gemm_phase(ldsp, g, S, E, tl); }
    SEAM(P_F2B);
    if (IN(P_LN3)) { LAUNDER(); ln_rows(out, nullptr, args.in[I_LN3G], args.in[I_LN3B], LANE(), gw, NGW); }
#undef IN
#undef SEAM
}

extern "C" void kernel_launch(void* const* d_in, const int* in_sizes, int n_in, void* d_out, int out_size, void* d_ws, size_t ws_size, hipStream_t stream) {
    static int grid = 0;
    if (grid == 0) {
        if (n_in != 24 || in_sizes[0] != M * D || out_size != M * D || ws_size < WS_END) { fprintf(stderr, "kernel_launch: shape mismatch n_in %d in0 %d out %d ws %zu\n", n_in, n_in > 0 ? in_sizes[0] : -1, out_size, ws_size); grid = -1; return; }
        int dev = 0, cus = 0, per_cu = 0;
        if (hipGetDevice(&dev) != hipSuccess || hipDeviceGetAttribute(&cus, hipDeviceAttributeMultiprocessorCount, dev) != hipSuccess) { grid = -1; return; }
        if (hipFuncSetAttribute((const void*)mega_fwd, hipFuncAttributeMaxDynamicSharedMemorySize, LDS_BYTES) != hipSuccess) { fprintf(stderr, "kernel_launch: hipFuncSetAttribute failed\n"); grid = -1; return; }
        if (hipOccupancyMaxActiveBlocksPerMultiprocessor(&per_cu, (const void*)mega_fwd, NWAVES * 64, LDS_BYTES) != hipSuccess || per_cu < 1) { fprintf(stderr, "kernel_launch: occupancy query says %d\n", per_cu); }
        (void)hipGetLastError();
        grid = cus;
        if (grid != 256) fprintf(stderr, "kernel_launch: %d CUs (built for 256)\n", grid);
    }
    if (grid < 0) return;
    if (hipMemsetAsync((char*)d_ws + WS_CTL, 0, CTL_ZERO_BYTES, stream) != hipSuccess) return;
    Args a{};
    for (int i = 0; i < 24; ++i) a.in[i] = (const float*)d_in[i];
    a.out = (float*)d_out; a.ws = (unsigned char*)d_ws;
#if MK_PER_PHASE
    for (int p = 0; p < MK_PH_END; ++p) { a.ph_lo = p; a.ph_hi = p + 1; hipLaunchKernelGGL(mega_fwd, dim3(grid), dim3(NWAVES * 64), LDS_BYTES, stream, a); }
#else
    a.ph_lo = 0; a.ph_hi = MK_PH_END;
    void* kargs[] = {&a};
    hipError_t e = hipLaunchCooperativeKernel((const void*)mega_fwd, dim3(grid), dim3(NWAVES * 64), kargs, LDS_BYTES, stream);
    if (e != hipSuccess) fprintf(stderr, "kernel_launch: cooperative launch failed: %s (grid %d)\n", hipGetErrorString(e), grid);
#endif
}
```

```cpp
#define MK_DUP_PHASE -1
#include <hip/hip_runtime.h>
#include <hip/hip_bf16.h>
#include <cstdio>
#include <cstdint>
#include <cmath>

#ifndef MK_PER_PHASE
#define MK_PER_PHASE 0
#endif
#ifndef MK_PHASE_MASK
#define MK_PHASE_MASK 0xFFFFFFFFu
#endif
#ifndef MK_ATT_MASK
#define MK_ATT_MASK 7
#endif
#ifndef MK_DUP_PHASE
#define MK_DUP_PHASE -1
#endif
#ifndef MK_PH_END
#define MK_PH_END 18
#endif

constexpr int D = 1024, BATCH = 2, SEQ = 8192, M = BATCH * SEQ, DFF = 2816;
constexpr int IN_COLS = 8736;
constexpr int NWIN = 5888;
constexpr float LN_EPS = 1e-5f;
constexpr float ALPHA = 1.189207115002721f;
constexpr float LOG2E = 1.4426950408889634f;
constexpr float C96 = 0.10206207261596575f * LOG2E;
constexpr float C128 = 0.08838834764831845f * LOG2E;

constexpr size_t MiB = 1u << 20;
constexpr size_t WS_CTL = 0, CTL_ZERO_BYTES = 1 * MiB;
constexpr size_t WS_ROPE = 1 * MiB;
constexpr size_t WS_SSQ = 2 * MiB, WS_SSKV = 2 * MiB + 128 * 1024;
constexpr size_t WS_LSE = 2 * MiB + 512 * 1024;
constexpr size_t WS_MEMB = 3 * MiB;
constexpr size_t WS_MEMK = 4 * MiB, WS_MEMV = 4 * MiB + 512 * 1024;
constexpr size_t WS_WGU = 5 * MiB;
constexpr size_t WS_WD = 16 * MiB;
constexpr size_t WS_WIN = 22 * MiB;
constexpr size_t WS_WING = 22 * MiB + (size_t)NWIN * 2048;
constexpr size_t WS_WUQ = 40 * MiB;
constexpr size_t WS_WUKV = 40 * MiB + 512 * 1024;
constexpr size_t WS_WMKV = 41 * MiB;
constexpr size_t WS_WBR = 43 * MiB;
constexpr size_t WS_WO = 46 * MiB;
constexpr size_t WS_AB = 48 * MiB;
constexpr size_t WS_H = 80 * MiB;
constexpr size_t WS_DIL = 80 * MiB;
constexpr size_t WS_Q = 152 * MiB;
constexpr size_t WS_KN = 164 * MiB;
constexpr size_t WS_V = 172 * MiB;
constexpr size_t WS_CQ = 180 * MiB, WS_CKV = 184 * MiB;
constexpr size_t WS_KPE = 188 * MiB;
constexpr size_t WS_OCAT = 208 * MiB;
constexpr size_t WS_GATES = 80 * MiB;
constexpr size_t WS_MERGED = 176 * MiB;
constexpr size_t WS_END = 256 * MiB;

constexpr int RING_BYTES = 131072;
constexpr int MISC_OFF = RING_BYTES + 320;
constexpr int LDS_BYTES = 147456;

#define GAS __attribute__((address_space(1)))
#define LAS __attribute__((address_space(3)))
typedef unsigned short bf16_t;
typedef short bf16x8 __attribute__((ext_vector_type(8)));
typedef short s16x4 __attribute__((ext_vector_type(4)));
typedef float f32x4 __attribute__((ext_vector_type(4)));
typedef float f32x2 __attribute__((ext_vector_type(2)));
typedef float f32x16 __attribute__((ext_vector_type(16)));
typedef unsigned u32x4 __attribute__((ext_vector_type(4)));
typedef unsigned u32x2 __attribute__((ext_vector_type(2)));

__device__ __forceinline__ unsigned f2bf(float f) { unsigned u = __builtin_bit_cast(unsigned, f); return (u + 0x7fffu + ((u >> 16) & 1u)) >> 16; }
__device__ __forceinline__ unsigned pk2(float lo, float hi) { return f2bf(lo) | (f2bf(hi) << 16); }
__device__ __forceinline__ unsigned cvt_pk_bf16(float lo, float hi) { unsigned r; asm volatile("v_cvt_pk_bf16_f32 %0, %1, %2" : "=v"(r) : "v"(lo), "v"(hi)); return r; }
__device__ __forceinline__ float bf_lo(unsigned w) { return __builtin_bit_cast(float, w << 16); }
__device__ __forceinline__ float bf_hi(unsigned w) { return __builtin_bit_cast(float, w & 0xffff0000u); }
__device__ __forceinline__ float shx(float v, int mask, int lane) { return __builtin_bit_cast(float, __builtin_amdgcn_ds_bpermute((lane ^ mask) << 2, __builtin_bit_cast(int, v))); }
__device__ __forceinline__ float fast_sigmoid(float x) { return __builtin_amdgcn_rcpf(1.0f + __builtin_amdgcn_exp2f(-x * LOG2E)); }

#define XB_TMO      128
#define XB_XCNT(j)  (256  + 64 * (j))
#define XB_XSUB(j)  (1280 + 64 * (j))
#define XB_XGEN(j)  (2304 + 64 * (j))
#define XB_TOP      3328
#define XB_TOPGEN   3392
#define XCD_BAR_WORDS 3456
#define XB_SPIN_CAP (1u << 18)
__device__ __forceinline__ unsigned xb_ld(unsigned* p)              { return __hip_atomic_load(p, __ATOMIC_RELAXED, __HIP_MEMORY_SCOPE_AGENT); }
__device__ __forceinline__ unsigned xb_add(unsigned* p, unsigned v) { return __hip_atomic_fetch_add(p, v, __ATOMIC_RELAXED, __HIP_MEMORY_SCOPE_AGENT); }
__device__ __forceinline__ unsigned xb_xcc_id() { return (unsigned)__builtin_amdgcn_s_getreg((3 << 11) | 20) & 0xFu; }
#define XB_SPIN(cond, bar) do { unsigned _sp = 0; while (cond) { __builtin_amdgcn_s_sleep(1); \
    if ((++_sp & 255u) == 0u) { if (xb_ld(&(bar)[XB_TMO])) break; if (_sp > XB_SPIN_CAP) { atomicAdd(&(bar)[XB_TMO], 1u); break; } } } } while (0)
struct XcdBarrier { unsigned* bar; unsigned x; volatile LAS unsigned* st; };
__device__ __forceinline__ XcdBarrier xcd_barrier_post(unsigned* bar, volatile LAS unsigned* st, int tid) {
    XcdBarrier b; b.bar = bar; b.x = xb_xcc_id(); b.st = st;
    if (tid == 0) (void)xb_add(&bar[XB_XCNT(b.x)], 1u);
    return b;
}
__device__ __forceinline__ void xcd_barrier_complete(unsigned* bar, unsigned x, unsigned& nloc, unsigned& nx) {
    const unsigned G = gridDim.x * gridDim.y * gridDim.z;
    unsigned sum, cnt, mine, sp = 0u;
    for (;;) {
        sum = 0u; cnt = 0u; mine = 0u;
#pragma unroll
        for (unsigned j = 0; j < 16; ++j) { const unsigned c = xb_ld(&bar[XB_XCNT(j)]); sum += c; cnt += (c > 0u) ? 1u : 0u; mine = (j == x) ? c : mine; }
        if (sum == G) break;
        __builtin_amdgcn_s_sleep(1);
        if ((++sp & 255u) == 0u) { if (xb_ld(&bar[XB_TMO])) break; if (sp > XB_SPIN_CAP) { atomicAdd(&bar[XB_TMO], 1u); break; } }
    }
    nloc = mine > 0u ? mine : 1u; nx = cnt > 0u ? cnt : 1u;
}
__device__ __forceinline__ void xcd_barrier(const XcdBarrier& b, int tid) {
    asm volatile("s_waitcnt vmcnt(0)" ::: "memory");
    __syncthreads();
    if (tid == 0) {
        unsigned* bar = b.bar;
        __builtin_amdgcn_s_waitcnt(0);
        unsigned nloc = b.st[0], nx = b.st[1];
        if (nloc == 0u) { xcd_barrier_complete(bar, b.x, nloc, nx); b.st[0] = nloc; b.st[1] = nx; }
        const unsigned old = xb_add(&bar[XB_XSUB(b.x)], 1u);
        const unsigned gen = old / nloc;
        if (old + 1u == (gen + 1u) * nloc) {
            __builtin_amdgcn_fence(__ATOMIC_RELEASE, "agent");
            asm volatile("s_waitcnt vmcnt(0)" ::: "memory");
            const unsigned og = xb_add(&bar[XB_TOP], 1u);
            const unsigned tg = og / nx;
            if (og + 1u == (tg + 1u) * nx) xb_add(&bar[XB_TOPGEN], 1u);
            else XB_SPIN(xb_ld(&bar[XB_TOPGEN]) == tg, bar);
            __builtin_amdgcn_fence(__ATOMIC_ACQUIRE, "agent");
            xb_add(&bar[XB_XGEN(b.x)], 1u);
            asm volatile("s_waitcnt vmcnt(0)" ::: "memory");
        } else {
            XB_SPIN(xb_ld(&bar[XB_XGEN(b.x)]) == gen, bar);
            __builtin_amdgcn_fence(__ATOMIC_ACQUIRE, "agent");
            asm volatile("s_waitcnt vmcnt(0)" ::: "memory");
        }
    }
    __syncthreads();
}

namespace pg8 {
constexpr int BM = 256, BK = 64, HALF = 128, HTB = HALF * BK * 2, NXCD = 8, WGM = 8;
__host__ __device__ __forceinline__ int lds_byte(int r, int c) { const int st = (r >> 4) * 2 + (c >> 5), rr = r & 15, cc = c & 31, ob = rr * 64 + cc * 2; return st * 1024 + (ob ^ (((ob >> 9) & 1) << 5)); }
__host__ __device__ __forceinline__ void stage_rc(int b, int& R, int& C) { const int st = b / 1024, sb = b % 1024, swz = sb ^ (((sb >> 9) & 1) << 5); R = (st >> 1) * 16 + swz / 64; C = (st & 1) * 32 + (swz % 64) / 2; }
__host__ __device__ __forceinline__ int perm32(int rho) { const int n = rho >> 4, i = rho & 15; return 8 * (i >> 2) + 4 * n + (i & 3); }

struct Unit { int pm, pn, am, bn, z; };
struct Gemm { const bf16_t* A; const bf16_t* Bt; int K; };

struct OrderStd {
    int nM, nN, nwg, G, c;
    __device__ void init(int M_, int N_, int G_, int c_) { nM = M_ / BM; nN = N_ / BM; nwg = nM * nN; G = G_; c = c_; }
    __device__ bool next(int i, Unit& u) const {
        const long L = (long)i * G + c; if (L >= nwg) return false;
        int wgid = (int)L; { const int q = nwg / NXCD, r = nwg % NXCD, xcd = wgid % NXCD, off = wgid / NXCD; wgid = (xcd < r ? xcd * (q + 1) : r * (q + 1) + (xcd - r) * q) + off; }
        const int nig = WGM * nN, gid = wgid / nig, fm = gid * WGM, gsz = (nM - fm) < WGM ? (nM - fm) : WGM;
        u.pm = fm + ((wgid % nig) % gsz); u.pn = (wgid % nig) / gsz; u.am = u.pm; u.bn = u.pn; u.z = 0; return true;
    }
};
template <int MODE> struct OrderTri {
    OrderStd base;
    __device__ bool next(int i, Unit& u) const {
        if (i >= 3) return false;
        if (!base.next(0, u)) return false;
        u.z = i; u.bn = 4 * i + u.pn; u.am = MODE ? 64 * i + u.pm : u.pm; return true;
    }
};

template <class Epi, class Sched>
__device__ __forceinline__ void gemm_phase(LAS unsigned char* lds, const Gemm g, const Sched& S, const Epi& E, const int tid) {
    const int wid = __builtin_amdgcn_readfirstlane(tid >> 6), lane = tid & 63, wr = wid >> 2, wc = wid & 3, fr = lane & 15, fq = lane >> 4;
    const int K = g.K, nt = K / BK;
    unsigned voffA[2], voffB[2];
#pragma unroll
    for (int i = 0; i < 2; ++i) { int R, C; stage_rc(tid * 16 + i * 8192, R, C); const int Rb = Epi::PERM ? ((R & ~31) + perm32(R & 31)) : R;
        voffA[i] = (unsigned)(R * K + C) * 2u; voffB[i] = (unsigned)(Rb * K + C) * 2u; }
    const size_t kstep = (size_t)(BK * 2);
    const size_t hstep = (size_t)HALF * K * 2;
    const size_t tstep = 2 * hstep;
    const unsigned ldsw = (unsigned)wid * 1024u;
    const int aoff = lds_byte(wr * 64 + fr, fq * 8), boff = lds_byte(wc * 32 + fr, fq * 8);
#define PG8_SA(b, h) (((b) * 2 + (h)) * HTB)
#define PG8_SB(b, h) ((4 + (b) * 2 + (h)) * HTB)
#define PG8_STAGE(bufoff, gbase, voff) do { _Pragma("unroll") for (int _i = 0; _i < 2; ++_i) \
        __builtin_amdgcn_global_load_lds((const unsigned*)((const char*)(gbase) + (voff)[_i]), (LAS unsigned*)(lds + (bufoff) + ldsw + _i * 8192), 16, 0, 0); } while (0)
#define PG8_LDA(dst, b, h) do { _Pragma("unroll") for (int m = 0; m < 4; ++m) _Pragma("unroll") for (int k = 0; k < 2; ++k) dst[m][k] = *(const LAS bf16x8*)(lds + PG8_SA(b, h) + aoff + m * 2048 + k * 1024); } while (0)
#define PG8_LDB(dst, b, h) do { _Pragma("unroll") for (int n = 0; n < 2; ++n) _Pragma("unroll") for (int k = 0; k < 2; ++k) dst[n][k] = *(const LAS bf16x8*)(lds + PG8_SB(b, h) + boff + n * 2048 + k * 1024); } while (0)
#define PG8_MMA(ai, bj, At, Bt) do { __builtin_amdgcn_s_setprio(1); _Pragma("unroll") for (int m = 0; m < 4; ++m) _Pragma("unroll") for (int n = 0; n < 2; ++n) _Pragma("unroll") for (int k = 0; k < 2; ++k) \
        acc[ai][bj][m][n] = __builtin_amdgcn_mfma_f32_16x16x32_bf16(Bt[n][k], At[m][k], acc[ai][bj][m][n], 0, 0, 0); __builtin_amdgcn_s_setprio(0); } while (0)
#define PG8_WAIT_V(n) asm volatile("s_waitcnt vmcnt(" #n ")" ::: "memory")
#define PG8_WAIT_L(n) asm volatile("s_waitcnt lgkmcnt(" #n ")" ::: "memory")
#define PG8_BAR __builtin_amdgcn_s_barrier()
#define PG8_SCHED __builtin_amdgcn_sched_barrier(0)
    Unit cur, nxt; int ui = 0;
    if (!S.next(0, cur)) return;
    f32x4 acc[2][2][4][2];
#pragma unroll
    for (int a = 0; a < 2; ++a)
#pragma unroll
        for (int b = 0; b < 2; ++b)
#pragma unroll
            for (int m = 0; m < 4; ++m)
#pragma unroll
                for (int n = 0; n < 2; ++n) acc[a][b][m][n] = (f32x4){0.f, 0.f, 0.f, 0.f};
    bf16x8 At[4][2], B0[2][2], B1[2][2];
    const char* cA = (const char*)g.A + (size_t)cur.am * tstep; const char* cB = (const char*)g.Bt + (size_t)cur.bn * tstep;
    PG8_STAGE(PG8_SB(0, 0), cB, voffB); PG8_STAGE(PG8_SB(0, 1), cB + hstep, voffB); PG8_STAGE(PG8_SA(0, 0), cA, voffA); PG8_STAGE(PG8_SA(0, 1), cA + hstep, voffA);
    if (wr == 1) PG8_BAR;
    PG8_WAIT_V(2); PG8_BAR;
    PG8_STAGE(PG8_SB(1, 0), cB + kstep, voffB); PG8_STAGE(PG8_SA(1, 0), cA + kstep, voffA); PG8_STAGE(PG8_SB(1, 1), cB + hstep + kstep, voffB);
    PG8_WAIT_V(6); PG8_BAR;
    for (;;) {
        const bool has_next = S.next(ui + 1, nxt);
        const char* nA = has_next ? (const char*)g.A + (size_t)nxt.am * tstep : cA; const char* nB = has_next ? (const char*)g.Bt + (size_t)nxt.bn * tstep : cB;
        for (int t = 0; t < nt; t += 2) {
            const bool last = (t == nt - 2);
            const char* a1 = cA + (size_t)(t + 1) * kstep;
            const char* a2 = last ? nA : cA + (size_t)(t + 2) * kstep; const char* b2 = last ? nB : cB + (size_t)(t + 2) * kstep;
            const char* a3 = a2 + kstep; const char* b3 = b2 + kstep;
            PG8_LDB(B0, 0, 0); PG8_LDB(B1, 0, 1); PG8_SCHED; PG8_LDA(At, 0, 0); PG8_STAGE(PG8_SA(1, 1), a1 + hstep, voffA);
            PG8_WAIT_V(8); PG8_WAIT_L(0); PG8_BAR; PG8_MMA(0, 0, At, B0); PG8_MMA(0, 1, At, B1); PG8_BAR; PG8_SCHED;
            PG8_LDA(At, 0, 1); PG8_STAGE(PG8_SB(0, 0), b2, voffB); PG8_STAGE(PG8_SB(0, 1), b2 + hstep, voffB); PG8_STAGE(PG8_SA(0, 0), a2, voffA);
            PG8_WAIT_V(8); PG8_WAIT_L(0); PG8_BAR; PG8_MMA(1, 0, At, B0); PG8_MMA(1, 1, At, B1); PG8_BAR; PG8_SCHED;
            PG8_LDB(B0, 1, 0); PG8_LDB(B1, 1, 1); PG8_SCHED; PG8_LDA(At, 1, 0); PG8_STAGE(PG8_SA(0, 1), a2 + hstep, voffA);
            PG8_WAIT_V(8); PG8_WAIT_L(0); PG8_BAR; PG8_MMA(0, 0, At, B0); PG8_MMA(0, 1, At, B1); PG8_BAR; PG8_SCHED;
            PG8_LDA(At, 1, 1); PG8_STAGE(PG8_SB(1, 0), b3, voffB); PG8_STAGE(PG8_SB(1, 1), b3 + hstep, voffB); PG8_STAGE(PG8_SA(1, 0), a3, voffA);
            PG8_WAIT_V(8); PG8_WAIT_L(0); PG8_BAR; PG8_MMA(1, 0, At, B0); PG8_MMA(1, 1, At, B1); PG8_BAR; PG8_SCHED;
        }
        if (wr == 0) PG8_BAR;
        { int t2 = tid; asm volatile("" : "+v"(t2)); const int l2 = t2 & 63; E(acc, cur, wr, wc, l2 & 15, l2 >> 4); }
        if (!has_next) break;
        if (!E.keep(cur)) {
#pragma unroll
            for (int a = 0; a < 2; ++a)
#pragma unroll
                for (int b = 0; b < 2; ++b)
#pragma unroll
                    for (int m = 0; m < 4; ++m)
#pragma unroll
                        for (int n = 0; n < 2; ++n) acc[a][b][m][n] = (f32x4){0.f, 0.f, 0.f, 0.f};
        }
        cur = nxt; cA = nA; cB = nB; ++ui;
        if (wr == 1) PG8_BAR;
    }
    PG8_WAIT_V(0);
    PG8_BAR;
#undef PG8_SA
#undef PG8_SB
#undef PG8_STAGE
#undef PG8_LDA
#undef PG8_LDB
#undef PG8_MMA
#undef PG8_WAIT_V
#undef PG8_WAIT_L
#undef PG8_BAR
#undef PG8_SCHED
}

typedef f32x4 Acc[2][2][4][2];
#define PG8_FOR_AI_M _Pragma("unroll") for (int ai = 0; ai < 2; ++ai) _Pragma("unroll") for (int m = 0; m < 4; ++m)

__device__ __forceinline__ u32x4 pack8(const f32x4 v0, const f32x4 v1) { u32x4 w; w.x = cvt_pk_bf16(v0[0], v0[1]); w.y = cvt_pk_bf16(v0[2], v0[3]); w.z = cvt_pk_bf16(v1[0], v1[1]); w.w = cvt_pk_bf16(v1[2], v1[3]); return w; }

struct EpiSwiglu {
    static constexpr bool PERM = true;
    bf16_t* H;
    __device__ __forceinline__ bool keep(const Unit&) const { return false; }
    __device__ __forceinline__ void operator()(Acc& acc, const Unit& u, int wr, int wc, int fr, int fq) const {
        const int row0 = u.pm * BM + wr * 64 + fr, col0 = u.pn * 128 + wc * 32 + 8 * fq;
        PG8_FOR_AI_M { f32x4 v[2];
#pragma unroll
            for (int n = 0; n < 2; ++n)
#pragma unroll
                for (int j = 0; j < 4; ++j) { const float gt = acc[ai][0][m][n][j], up = acc[ai][1][m][n][j]; v[n][j] = gt * fast_sigmoid(gt) * up; }
            *(u32x4*)(H + (size_t)(row0 + ai * HALF + m * 16) * DFF + col0) = pack8(v[0], v[1]); }
    }
};
struct EpiResid {
    static constexpr bool PERM = false;
    const float* base; float* out; float alpha, s;
    __device__ __forceinline__ bool keep(const Unit&) const { return false; }
    __device__ __forceinline__ void operator()(Acc& acc, const Unit& u, int wr, int wc, int fr, int fq) const {
        const int col0 = u.pn * BM + wc * 32 + 4 * fq;
        PG8_FOR_AI_M { const size_t off = (size_t)(u.pm * BM + ai * HALF + wr * 64 + m * 16 + fr) * D + col0;
#pragma unroll
            for (int bj = 0; bj < 2; ++bj)
#pragma unroll
                for (int n = 0; n < 2; ++n) { const f32x4 bs = *(const f32x4*)(base + off + bj * HALF + n * 16); *(f32x4*)(out + off + bj * HALF + n * 16) = bs * alpha + acc[ai][bj][m][n] * s; } }
    }
};
__device__ __forceinline__ void rope32(f32x4 (&v)[2], const float* rope, int pos, int fq, int lane) {
    const float* cs = rope + (size_t)pos * 16 + 8 * (fq & 1); const float* sn = cs + SEQ * 16;
#pragma unroll
    for (int n = 0; n < 2; ++n) { const f32x4 c = *(const f32x4*)(cs + 4 * n), s = *(const f32x4*)(sn + 4 * n);
#pragma unroll
        for (int j = 0; j < 4; ++j) { const float x = v[n][j], p = shx(x, 32, lane); v[n][j] = x * c[j] + ((fq < 2) ? -p : p) * s[j]; } }
}
struct EpiWin {
    static constexpr bool PERM = true;
    bf16_t *CQ, *CKV, *KPE, *MEMQ, *DIL; float *SSQ, *SSKV; const float* rope;
    __device__ __forceinline__ bool keep(const Unit&) const { return false; }
    __device__ __forceinline__ void operator()(Acc& acc, const Unit& u, int wr, int wc, int fr, int fq) const {
        const int row0 = u.pm * BM + wr * 64 + fr, cw = wc * 32 + 8 * fq, pn = u.pn;
        if (pn < 2) {
            bf16_t* O = pn ? CKV : CQ; float* SS = pn ? SSKV : SSQ;
            PG8_FOR_AI_M { const int row = row0 + ai * HALF + m * 16; float s = 0.f;
#pragma unroll
                for (int bj = 0; bj < 2; ++bj) { const f32x4 a = acc[ai][bj][m][0], b = acc[ai][bj][m][1];
                    s += (a[0] * a[0] + a[1] * a[1]) + (a[2] * a[2] + a[3] * a[3]) + (b[0] * b[0] + b[1] * b[1]) + (b[2] * b[2] + b[3] * b[3]);
                    *(u32x4*)(O + (size_t)row * 256 + bj * HALF + cw) = pack8(a, b); }
                s += shx(s, 16, fq * 16 + fr); s += shx(s, 32, fq * 16 + fr);
                if (fq == 0) SS[row * 4 + wc] = s; asm volatile("" ::: "memory"); }
        } else if (pn == 2) {
            if (wc == 0) {
                PG8_FOR_AI_M { const int row = row0 + ai * HALF + m * 16; f32x4 v[2] = {acc[ai][0][m][0], acc[ai][0][m][1]};
                    rope32(v, rope, row, fq, fq * 16 + fr);
                    *(u32x4*)(KPE + (size_t)row * 32 + 8 * fq) = pack8(v[0], v[1]); asm volatile("" ::: "memory"); }
            }
        } else if (pn < 5) {
            PG8_FOR_AI_M { const int row = row0 + ai * HALF + m * 16;
#pragma unroll
                for (int bj = 0; bj < 2; ++bj) *(u32x4*)(MEMQ + (size_t)row * 512 + (pn - 3) * 256 + bj * HALF + cw) = pack8(acc[ai][bj][m][0] * C128, acc[ai][bj][m][1] * C128); }
        } else {
            const float sc = (pn - 5 < 6) ? C128 : 1.0f;
            PG8_FOR_AI_M { const int row = row0 + ai * HALF + m * 16;
#pragma unroll
                for (int bj = 0; bj < 2; ++bj) *(u32x4*)(DIL + (size_t)row * 4608 + (pn - 5) * 256 + bj * HALF + cw) = pack8(acc[ai][bj][m][0] * sc, acc[ai][bj][m][1] * sc); }
        }
    }
};
struct EpiQup {
    static constexpr bool PERM = true;
    bf16_t* Q; const float* SS; const float* rope;
    __device__ __forceinline__ bool keep(const Unit&) const { return false; }
    __device__ __forceinline__ void operator()(Acc& acc, const Unit& u, int wr, int wc, int fr, int fq) const {
        const int row0 = u.pm * BM + wr * 64 + fr, cw = wc * 32 + 8 * fq;
        PG8_FOR_AI_M { const int row = row0 + ai * HALF + m * 16; const f32x4 ss = *(const f32x4*)(SS + row * 4);
            const float rs = C96 / sqrtf(((ss[0] + ss[1]) + (ss[2] + ss[3])) * (1.0f / 256.0f) + LN_EPS);
#pragma unroll
            for (int bj = 0; bj < 2; ++bj) { f32x4 v[2] = {acc[ai][bj][m][0] * rs, acc[ai][bj][m][1] * rs};
                if ((u.pn * 8 + bj * 4 + wc) % 3 == 2) rope32(v, rope, row, fq, fq * 16 + fr);
                *(u32x4*)(Q + (size_t)row * 768 + u.pn * BM + bj * HALF + cw) = pack8(v[0], v[1]); } asm volatile("" ::: "memory"); }
    }
};
struct EpiKVup {
    static constexpr bool PERM = true;
    bf16_t *KN, *V; const float* SS;
    __device__ __forceinline__ bool keep(const Unit&) const { return false; }
    __device__ __forceinline__ void operator()(Acc& acc, const Unit& u, int wr, int wc, int fr, int fq) const {
        const int row0 = u.pm * BM + wr * 64 + fr; bf16_t* O = (wc < 2) ? KN : V; const int cw = (wc & 1) * 32 + 8 * fq;
        PG8_FOR_AI_M { const int row = row0 + ai * HALF + m * 16; const f32x4 ss = *(const f32x4*)(SS + row * 4);
            const float rs = 1.0f / sqrtf(((ss[0] + ss[1]) + (ss[2] + ss[3])) * (1.0f / 256.0f) + LN_EPS);
#pragma unroll
            for (int bj = 0; bj < 2; ++bj) *(u32x4*)(O + (size_t)row * 512 + (u.pn * 2 + bj) * 64 + cw) = pack8(acc[ai][bj][m][0] * rs, acc[ai][bj][m][1] * rs); asm volatile("" ::: "memory"); }
    }
};
struct EpiMemKV {
    static constexpr bool PERM = true;
    bf16_t *MK, *MV;
    __device__ __forceinline__ bool keep(const Unit&) const { return false; }
    __device__ __forceinline__ void operator()(Acc& acc, const Unit& u, int wr, int wc, int fr, int fq) const {
        const int row0 = u.pm * BM + wr * 64 + fr, cw = wc * 32 + 8 * fq; bf16_t* O = (u.pn < 2) ? MK : MV;
        PG8_FOR_AI_M { const int row = row0 + ai * HALF + m * 16;
#pragma unroll
            for (int bj = 0; bj < 2; ++bj) *(u32x4*)(O + (size_t)row * 512 + (u.pn & 1) * BM + bj * HALF + cw) = pack8(acc[ai][bj][m][0], acc[ai][bj][m][1]); }
    }
};
struct EpiGate {
    static constexpr bool PERM = true;
    u32x4* G;
    __device__ __forceinline__ bool keep(const Unit&) const { return false; }
    __device__ __forceinline__ void operator()(Acc& acc, const Unit& u, int wr, int wc, int fr, int fq) const {
        u32x4* g = G + (size_t)u.z * 16 * 512 + ((wr * 4 + wc) * 64 + fq * 16 + fr);
        PG8_FOR_AI_M {
#pragma unroll
            for (int bj = 0; bj < 2; ++bj) { f32x4 v[2];
#pragma unroll
                for (int n = 0; n < 2; ++n)
#pragma unroll
                    for (int j = 0; j < 4; ++j) v[n][j] = fmaxf(fast_sigmoid(acc[ai][bj][m][n][j]), 1e-9f);
                g[((ai * 4 + m) * 2 + bj) * 512] = pack8(v[0], v[1]); } }
    }
};
struct EpiBranch {
    static constexpr bool PERM = true;
    const u32x4* G; bf16_t* MG;
    __device__ __forceinline__ bool keep(const Unit& u) const { return u.z < 2; }
    __device__ __forceinline__ void operator()(Acc& acc, const Unit& u, int wr, int wc, int fr, int fq) const {
        const u32x4* g = G + (size_t)u.z * 16 * 512 + ((wr * 4 + wc) * 64 + fq * 16 + fr);
        const int row0 = u.pm * BM + wr * 64 + fr, cw = u.pn * BM + wc * 32 + 8 * fq;
        PG8_FOR_AI_M {
#pragma unroll
            for (int bj = 0; bj < 2; ++bj) { const int slot = ((ai * 4 + m) * 2 + bj) * 512; const u32x4 a = g[slot];
                float ga[8] = {bf_lo(a.x), bf_hi(a.x), bf_lo(a.y), bf_hi(a.y), bf_lo(a.z), bf_hi(a.z), bf_lo(a.w), bf_hi(a.w)};
                if (u.z < 2) { const u32x4 b = g[slot + 16 * 512];
                    const float gb[8] = {bf_lo(b.x), bf_hi(b.x), bf_lo(b.y), bf_hi(b.y), bf_lo(b.z), bf_hi(b.z), bf_lo(b.w), bf_hi(b.w)};
#pragma unroll
                    for (int e = 0; e < 8; ++e) ga[e] = ga[e] * __builtin_amdgcn_rcpf(gb[e]); }
#pragma unroll
                for (int n = 0; n < 2; ++n)
#pragma unroll
                    for (int j = 0; j < 4; ++j) acc[ai][bj][m][n][j] *= ga[n * 4 + j];
                if (u.z == 2) *(u32x4*)(MG + (size_t)(row0 + ai * HALF + m * 16) * D + bj * HALF + cw) = pack8(acc[ai][bj][m][0], acc[ai][bj][m][1]); } }
    }
};
}

namespace att {
constexpr int NW = 8, QBLK = 32, KVBLK = 64;
constexpr int SHM_K = 64 * 256;
#define SBAR() __builtin_amdgcn_sched_barrier(0)
__device__ __forceinline__ int crow(int r, int hi) { return (r & 3) + 8 * (r >> 2) + 4 * hi; }
struct Params {
    const bf16_t* Q; long ldq;
    const bf16_t* K; long ldk;
    const bf16_t* KP; long ldkp;
    const bf16_t* V; long ldv;
    bf16_t* O; long ldo;
    float* LSE; long ldlse;
    int NT;
    int kbase;
    int i0, L;
    float slope;
};
template <int DV> __device__ __forceinline__ int v_st(int k, int c) { const int kk = (k & ~0xC) | ((k & 4) << 1) | ((k & 8) >> 1); return ((kk >> 3) * (DV / 32) + (c >> 5)) * 512 + ((kk & 7) * 32 + (c & 31)) * 2; }
__device__ __forceinline__ int v_rd_base(int lane) { return ((lane & 3) << 3) | (((lane >> 2) & 3) << 6) | (((lane >> 4) & 1) << 5) | (((lane >> 5) & 1) << 8); }
template <int OFF> __device__ __forceinline__ s16x4 tr_read(int vb) { s16x4 r; asm volatile("ds_read_b64_tr_b16 %0, %1 offset:%2" : "=&v"(r) : "v"(vb), "i"(OFF) : "memory"); return r; }
template <int DV, int D0> __device__ __forceinline__ void pv_one(f32x16& od, int vb, bf16x8 pa0, bf16x8 pa1, bf16x8 pa2, bf16x8 pa3) {
    constexpr int KS = 2 * (DV / 32) * 512, HF = (DV / 32) * 512, B = D0 * 512;
    const s16x4 l0 = tr_read<B + 0 * KS>(vb), h0 = tr_read<B + 0 * KS + HF>(vb), l1 = tr_read<B + 1 * KS>(vb), h1 = tr_read<B + 1 * KS + HF>(vb);
    const s16x4 l2 = tr_read<B + 2 * KS>(vb), h2 = tr_read<B + 2 * KS + HF>(vb), l3 = tr_read<B + 3 * KS>(vb), h3 = tr_read<B + 3 * KS + HF>(vb);
    asm volatile("s_waitcnt lgkmcnt(0)" ::: "memory"); SBAR();
#define ATT_PK(Lo, Hi) (bf16x8){Lo[0], Lo[1], Lo[2], Lo[3], Hi[0], Hi[1], Hi[2], Hi[3]}
    od = __builtin_amdgcn_mfma_f32_32x32x16_bf16(pa0, ATT_PK(l0, h0), od, 0, 0, 0);
    od = __builtin_amdgcn_mfma_f32_32x32x16_bf16(pa1, ATT_PK(l1, h1), od, 0, 0, 0);
    od = __builtin_amdgcn_mfma_f32_32x32x16_bf16(pa2, ATT_PK(l2, h2), od, 0, 0, 0);
    od = __builtin_amdgcn_mfma_f32_32x32x16_bf16(pa3, ATT_PK(l3, h3), od, 0, 0, 0);
#undef ATT_PK
}
template <int DV> __device__ __forceinline__ void pv_all(f32x16* o, int vb, bf16x8 pa0, bf16x8 pa1, bf16x8 pa2, bf16x8 pa3) {
    pv_one<DV, 0>(o[0], vb, pa0, pa1, pa2, pa3); pv_one<DV, 1>(o[1], vb, pa0, pa1, pa2, pa3);
    if constexpr (DV == 128) { pv_one<DV, 2>(o[2], vb, pa0, pa1, pa2, pa3); pv_one<DV, 3>(o[3], vb, pa0, pa1, pa2, pa3); }
}
constexpr float THR2 = 5.0f;
constexpr float NEGBIG = -3.0e38f;
__device__ __forceinline__ void partialSM(f32x16& p0, f32x16& p1, float& m_reg, float& alpha) {
    float pmax = p0[0];
#pragma unroll
    for (int r = 1; r < 16; ++r) pmax = fmaxf(pmax, p0[r]);
#pragma unroll
    for (int r = 0; r < 16; ++r) pmax = fmaxf(pmax, p1[r]);
    { auto rr = __builtin_amdgcn_permlane32_swap(__float_as_uint(pmax), __float_as_uint(pmax), false, false); pmax = fmaxf(__uint_as_float(rr[0]), __uint_as_float(rr[1])); }
    float mn;
    if (__builtin_expect(__all(pmax - m_reg <= THR2), 1)) { mn = m_reg; alpha = 1.f; }
    else { mn = fmaxf(m_reg, pmax); alpha = __builtin_amdgcn_exp2f(m_reg - mn); m_reg = mn; }
#pragma unroll
    for (int r = 0; r < 16; ++r) p0[r] = p0[r] - mn;
#pragma unroll
    for (int r = 0; r < 16; ++r) p1[r] = p1[r] - mn;
#pragma unroll
    for (int r = 0; r < 16; ++r) p0[r] = __builtin_amdgcn_exp2f(p0[r]);
}
__device__ __forceinline__ void finishSM(f32x16& p0, f32x16& p1, float alpha, float& l_reg, bf16x8& pa0, bf16x8& pa1, bf16x8& pa2, bf16x8& pa3) {
#pragma unroll
    for (int r = 0; r < 16; ++r) p1[r] = __builtin_amdgcn_exp2f(p1[r]);
    float ps = 0;
#pragma unroll
    for (int r = 0; r < 16; ++r) ps += p0[r];
#pragma unroll
    for (int r = 0; r < 16; ++r) ps += p1[r];
    { auto rr = __builtin_amdgcn_permlane32_swap(__float_as_uint(ps), __float_as_uint(ps), false, false); ps = __uint_as_float(rr[0]) + __uint_as_float(rr[1]); }
    l_reg = l_reg * alpha + ps;
#define ATT_PK4(P, BASE, OUT) do { unsigned a0 = cvt_pk_bf16(P[BASE + 0], P[BASE + 1]), a1 = cvt_pk_bf16(P[BASE + 2], P[BASE + 3]);   \
    unsigned b0 = cvt_pk_bf16(P[BASE + 4], P[BASE + 5]), b1 = cvt_pk_bf16(P[BASE + 6], P[BASE + 7]);                              \
    auto r0 = __builtin_amdgcn_permlane32_swap(a0, b0, false, false); auto r1 = __builtin_amdgcn_permlane32_swap(a1, b1, false, false); \
    u32x4 w = {r0[0], r1[0], r0[1], r1[1]}; OUT = __builtin_bit_cast(bf16x8, w); } while (0)
    ATT_PK4(p0, 0, pa0); ATT_PK4(p0, 8, pa1); ATT_PK4(p1, 0, pa2); ATT_PK4(p1, 8, pa3);
#undef ATT_PK4
}
template <int DQK> __device__ __forceinline__ void qkt(f32x16& p0, f32x16& p1, const char* Ks, const bf16x8* qr, int r32, int hi) {
    p0 = f32x16{}; p1 = f32x16{};
#pragma unroll
    for (int d0 = 0; d0 < DQK / 16; ++d0) { const int ch = d0 * 2 + hi;
        const bf16x8 b0 = *reinterpret_cast<const bf16x8*>(Ks + r32 * 256 + ((ch ^ (r32 & 7)) << 4));
        const bf16x8 b1 = *reinterpret_cast<const bf16x8*>(Ks + (32 + r32) * 256 + ((ch ^ (r32 & 7)) << 4));
        p0 = __builtin_amdgcn_mfma_f32_32x32x16_bf16(b0, qr[d0], p0, 0, 0, 0);
        p1 = __builtin_amdgcn_mfma_f32_32x32x16_bf16(b1, qr[d0], p1, 0, 0, 0); }
}
__device__ __forceinline__ void dil_mask(f32x16& p0, f32x16& p1, int base, int rlo, int rhi, float slope) {
    asm volatile("" : "+v"(base));
#pragma unroll
    for (int r = 0; r < 16; ++r) { const int rel = base + (r & 3) + 8 * (r >> 2), rel1 = rel + 32;
        p0[r] = (rel >= rlo && rel <= rhi) ? p0[r] - slope * fabsf((float)rel) : NEGBIG;
        p1[r] = (rel1 >= rlo && rel1 <= rhi) ? p1[r] - slope * fabsf((float)rel1) : NEGBIG; }
}

template <int DQK, int DV, int MODE>
__device__ __forceinline__ void attn_unit(const Params& P, char* lds, const int tid) {
    constexpr int SHM_V = KVBLK * DV * 2;
    constexpr int NKL = (DQK == 128) ? 2 : 2, NVL = (DV == 128) ? 2 : 1;
    const int wid = tid >> 6, lane = tid & 63, r32 = lane & 31, hi = lane >> 5;
    char* V_lds = lds; char* K_lds = lds + 2 * SHM_V;
    float* ws = (float*)(lds + 2 * SHM_V + 2 * SHM_K) + wid * 64; float* li_l = ws; float* al_l = ws + 32;
    float m_reg = -1e30f, l_reg = 0; f32x16 o[DV / 32]; bf16x8 qr[DQK / 16];
#pragma unroll
    for (int d = 0; d < DV / 32; ++d) o[d] = f32x16{};
    { const bf16_t* Qw = P.Q + (long)(wid * QBLK + r32) * P.ldq + hi * 8;
#pragma unroll
      for (int d0 = 0; d0 < DQK / 16; ++d0) qr[d0] = *reinterpret_cast<const bf16x8*>(Qw + d0 * 16); }
    int krow[NKL], kch[NKL], vrow[NVL], vch[NVL];
    if constexpr (DQK == 128) { krow[0] = tid >> 4; krow[1] = 32 + (tid >> 4); kch[0] = kch[1] = tid & 15; }
    else { krow[0] = tid >> 3; kch[0] = tid & 7; krow[1] = (tid >> 2) & 63; kch[1] = 8 + (tid & 3); }
    if constexpr (DV == 128) { vrow[0] = tid >> 4; vrow[1] = 32 + (tid >> 4); vch[0] = vch[1] = tid & 15; }
    else { vrow[0] = tid >> 3; vch[0] = tid & 7; }
    const bool kpe_on = (MODE != 0) || (tid < 256);
    const int vb0 = (int)(uintptr_t)V_lds + v_rd_base(lane);
    constexpr int SD = (MODE != 0) ? 1 : 2, SE = 0, SO = SD - 1;
    struct Slot { bf16x8 k[NKL]; bf16x8 v[NVL]; } sr_[SD];
    auto keyrow = [&](int t, int row) -> long { long kr = (long)t * KVBLK + row; if constexpr (MODE == 2) { kr += P.kbase; kr = kr < 0 ? 0 : (kr >= P.L ? P.L - 1 : kr); } return kr; };
#define ATT_SLOAD(i, t) do { \
    if constexpr (MODE == 0) { sr_[i].k[0] = *reinterpret_cast<const bf16x8*>(P.K + keyrow(t, krow[0]) * P.ldk + kch[0] * 8); \
        if (kpe_on) sr_[i].k[1] = *reinterpret_cast<const bf16x8*>(P.KP + keyrow(t, krow[1]) * P.ldkp + (kch[1] - 8) * 8); } \
    else { _Pragma("unroll") for (int q_ = 0; q_ < NKL; ++q_) sr_[i].k[q_] = *reinterpret_cast<const bf16x8*>(P.K + keyrow(t, krow[q_]) * P.ldk + kch[q_] * 8); } \
    _Pragma("unroll") for (int q_ = 0; q_ < NVL; ++q_) sr_[i].v[q_] = *reinterpret_cast<const bf16x8*>(P.V + keyrow(t, vrow[q_]) * P.ldv + vch[q_] * 8); } while (0)
#define ATT_SWRITE(b, i) do { \
    _Pragma("unroll") for (int q_ = 0; q_ < NVL; ++q_) *(bf16x8*)(V_lds + (b) * SHM_V + v_st<DV>(vrow[q_], vch[q_] * 8)) = sr_[i].v[q_]; \
    *(bf16x8*)(K_lds + (b) * SHM_K + krow[0] * 256 + ((kch[0] ^ (krow[0] & 7)) << 4)) = sr_[i].k[0]; \
    if (kpe_on) *(bf16x8*)(K_lds + (b) * SHM_K + krow[1] * 256 + ((kch[1] ^ (krow[1] & 7)) << 4)) = sr_[i].k[1]; } while (0)
#define ATT_RESC(a) do { if (__any((a) < 1.f)) { if (hi == 0) al_l[r32] = (a); asm volatile("s_waitcnt lgkmcnt(0)" ::: "memory"); \
    _Pragma("unroll") for (int d = 0; d < DV / 32; ++d) _Pragma("unroll") for (int r = 0; r < 16; ++r) o[d][r] *= al_l[crow(r, hi)]; } } while (0)
#define ATT_MASK(p0, p1, t) do { if constexpr (MODE == 2) dil_mask(p0, p1, P.kbase + (t) * KVBLK + 4 * hi - iq, rlo, rhi, P.slope); } while (0)
    const int iq = P.i0 + wid * QBLK + r32; const int rlo = (-iq > -64) ? -iq : -64, rhi = (P.L - 1 - iq < 64) ? P.L - 1 - iq : 64;
    bf16x8 pa0, pa1, pa2, pa3; const int NT = P.NT;
    if constexpr (MODE == 0) {
    f32x16 pA0, pA1, pB0, pB1; float alA, alB;
    ATT_SLOAD(SE, 0); asm volatile("s_waitcnt vmcnt(0)" ::: "memory"); ATT_SWRITE(0, SE); __syncthreads();
    qkt<DQK>(pA0, pA1, K_lds, qr, r32, hi); ATT_MASK(pA0, pA1, 0); partialSM(pA0, pA1, m_reg, alA);
    ATT_SLOAD(SO, 1); if constexpr (SD == 2) { if (2 < NT) ATT_SLOAD(SE, 2); }
    ATT_SWRITE(1, SO); __syncthreads();
    for (int j = 1; j + 1 < NT; j += 2) {
        SBAR(); qkt<DQK>(pB0, pB1, K_lds + SHM_K, qr, r32, hi); ATT_MASK(pB0, pB1, j);
        finishSM(pA0, pA1, alA, l_reg, pa0, pa1, pa2, pa3); SBAR();
        ATT_SLOAD(SO, j + SD); SBAR();
        pv_all<DV>(o, vb0, pa0, pa1, pa2, pa3); partialSM(pB0, pB1, m_reg, alB);
        __syncthreads(); ATT_SWRITE(0, SE);
        ATT_RESC(alB); __syncthreads();
        SBAR(); qkt<DQK>(pA0, pA1, K_lds, qr, r32, hi); ATT_MASK(pA0, pA1, j + 1);
        finishSM(pB0, pB1, alB, l_reg, pa0, pa1, pa2, pa3); SBAR();
        if (SD == 1 || j + 3 < NT) ATT_SLOAD(SE, j + 1 + SD); SBAR();
        pv_all<DV>(o, vb0 + SHM_V, pa0, pa1, pa2, pa3); partialSM(pA0, pA1, m_reg, alA);
        __syncthreads(); ATT_SWRITE(1, SO);
        ATT_RESC(alA); __syncthreads();
    }
    SBAR(); qkt<DQK>(pB0, pB1, K_lds + SHM_K, qr, r32, hi); ATT_MASK(pB0, pB1, NT - 1);
    finishSM(pA0, pA1, alA, l_reg, pa0, pa1, pa2, pa3); SBAR();
    pv_all<DV>(o, vb0, pa0, pa1, pa2, pa3); partialSM(pB0, pB1, m_reg, alB);
    __syncthreads(); ATT_RESC(alB);
    finishSM(pB0, pB1, alB, l_reg, pa0, pa1, pa2, pa3); SBAR();
    pv_all<DV>(o, vb0 + SHM_V, pa0, pa1, pa2, pa3);
    } else {
        ATT_SLOAD(0, 0); asm volatile("s_waitcnt vmcnt(0)" ::: "memory"); ATT_SWRITE(0, 0); __syncthreads();
        for (int t = 0; t < NT; ++t) {
            const int bsel = t & 1;
            if (t + 1 < NT) ATT_SLOAD(0, t + 1);
            f32x16 p0, p1; float al;
            qkt<DQK>(p0, p1, K_lds + bsel * SHM_K, qr, r32, hi); ATT_MASK(p0, p1, t);
            partialSM(p0, p1, m_reg, al); ATT_RESC(al);
            finishSM(p0, p1, al, l_reg, pa0, pa1, pa2, pa3); SBAR();
            pv_all<DV>(o, vb0 + bsel * SHM_V, pa0, pa1, pa2, pa3);
            if (t + 1 < NT) { ATT_SWRITE(bsel ^ 1, 0); }
            __syncthreads();
        }
    }
    if (hi == 0) li_l[r32] = l_reg; asm volatile("s_waitcnt lgkmcnt(0)" ::: "memory");
    if constexpr (MODE == 2) { if (hi == 0) P.LSE[(long)(wid * QBLK + r32) * P.ldlse] = m_reg + __builtin_amdgcn_logf(l_reg); }
    float rli[16];
#pragma unroll
    for (int r = 0; r < 16; ++r) rli[r] = __builtin_amdgcn_rcpf(li_l[crow(r, hi)]);
    bf16_t* Ow = P.O + (long)(wid * QBLK) * P.ldo;
#pragma unroll
    for (int r = 0; r < 16; ++r) { const int orow = crow(r, hi);
#pragma unroll
        for (int d0 = 0; d0 < DV / 32; ++d0) Ow[(long)orow * P.ldo + d0 * 32 + r32] = (bf16_t)f2bf(o[d0][r] * rli[r]); }
    __syncthreads();
#undef ATT_SLOAD
#undef ATT_SWRITE
#undef ATT_RESC
#undef ATT_MASK
}

typedef short v4i16_t __attribute__((ext_vector_type(4)));
__device__ __forceinline__ s16x4 vtr(const LAS char* p) { return __builtin_bit_cast(s16x4, __builtin_amdgcn_ds_read_tr16_b64_v4i16((LAS v4i16_t*)p)); }
constexpr int PP_K = 0, PP_V = 3 * 16384, PP_WS = PP_V + 4 * 8192;
constexpr float PP_THR = 6.0f;
__device__ __forceinline__ void mla_unit_pp(const Params& P, LAS char* lds, const int tid) {
    const int wid = __builtin_amdgcn_readfirstlane(tid >> 6), lane = tid & 63, r32 = lane & 31, hi = lane >> 5, grp = wid >> 2;
    LAS float* wsf = (LAS float*)(lds + PP_WS) + wid * 64;
    bf16x8 qr[6];
    { const bf16_t* Qw = P.Q + (long)(wid * QBLK + r32) * P.ldq + hi * 8;
#pragma unroll
      for (int d0 = 0; d0 < 6; ++d0) qr[d0] = *reinterpret_cast<const bf16x8*>(Qw + d0 * 16); }
    const int srow = tid >> 3, sch = tid & 7, prow = (tid >> 2) & 63, pch = 8 + (tid & 3);
    const bool pe_on = tid < 256;
    const bf16_t* gK = P.K + (long)srow * P.ldk + sch * 8;
    const bf16_t* gP = P.KP + (long)prow * P.ldkp + (pch - 8) * 8;
    const bf16_t* gV = P.V + (long)srow * P.ldv + sch * 8;
    const int kw0 = srow * 256 + ((sch ^ (srow & 7)) << 4), kw1 = prow * 256 + ((pch ^ (prow & 7)) << 4), vw = v_st<64>(srow, sch * 8);
    bf16x8 sk, sp, sv;
#define PP_LOAD(t) do { sk = *reinterpret_cast<const bf16x8*>(gK + (long)(t) * 64 * P.ldk); if (pe_on) sp = *reinterpret_cast<const bf16x8*>(gP + (long)(t) * 64 * P.ldkp); \
                        sv = *reinterpret_cast<const bf16x8*>(gV + (long)(t) * 64 * P.ldv); } while (0)
#define PP_WRITE(kb, vb) do { *(LAS bf16x8*)(lds + PP_K + (kb) + kw0) = sk; if (pe_on) *(LAS bf16x8*)(lds + PP_K + (kb) + kw1) = sp; *(LAS bf16x8*)(lds + PP_V + (vb) + vw) = sv; } while (0)
#define PP_BAR() do { __builtin_amdgcn_sched_barrier(0); asm volatile("s_waitcnt lgkmcnt(0)" ::: "memory"); __builtin_amdgcn_s_barrier(); __builtin_amdgcn_sched_barrier(0); } while (0)
    const int kr0 = r32 * 256, kr1 = (32 + r32) * 256, ksw = r32 & 7;
    const int vrb = v_rd_base(lane);
    PP_LOAD(0); PP_WRITE(0, 0); PP_LOAD(1); PP_WRITE(16384, 8192);
    asm volatile("s_waitcnt vmcnt(0) lgkmcnt(0)" ::: "memory"); __builtin_amdgcn_s_barrier();
    PP_LOAD(2);
    float mref = 0.f, l_reg = 0.f; f32x16 o0 = f32x16{}, o1 = f32x16{}, negm = f32x16{};
    bf16x8 pa0, pa1, pa2, pa3; pa0 = pa1 = pa2 = pa3 = (bf16x8){0, 0, 0, 0, 0, 0, 0, 0};
    bool first = true;
    int kb_r = 0, vb_r = 0, vb_p = 0;
    int kb_w = 2 * 16384, vb_w = 2 * 8192;
    const int NT = P.NT;
    if (grp == 1) __builtin_amdgcn_s_barrier();
    for (int j = 0; j < NT; ++j) {
        f32x16 s0, s1;
        {
            const LAS char* kb = lds + PP_K + kb_r; const LAS char* vb = lds + PP_V + vb_p + vrb;
            bf16x8 k0[6], k1[6]; s16x4 vl[8], vh[8];
#pragma unroll
            for (int d0 = 0; d0 < 6; ++d0) { const int co = ((2 * d0 + hi) ^ ksw) << 4; k0[d0] = *(const LAS bf16x8*)(kb + kr0 + co); k1[d0] = *(const LAS bf16x8*)(kb + kr1 + co); }
#pragma unroll
            for (int i = 0; i < 8; ++i) { vl[i] = vtr(vb + (i >> 2) * 512 + (i & 3) * 2048); vh[i] = vtr(vb + (i >> 2) * 512 + (i & 3) * 2048 + 1024); }
            __builtin_amdgcn_s_setprio(1);
            s0 = __builtin_amdgcn_mfma_f32_32x32x16_bf16(k0[0], qr[0], negm, 0, 0, 0);
            s1 = __builtin_amdgcn_mfma_f32_32x32x16_bf16(k1[0], qr[0], negm, 0, 0, 0);
#pragma unroll
            for (int d0 = 1; d0 < 6; ++d0) { s0 = __builtin_amdgcn_mfma_f32_32x32x16_bf16(k0[d0], qr[d0], s0, 0, 0, 0); s1 = __builtin_amdgcn_mfma_f32_32x32x16_bf16(k1[d0], qr[d0], s1, 0, 0, 0); }
#define PP_VF(i) (bf16x8){vl[i][0], vl[i][1], vl[i][2], vl[i][3], vh[i][0], vh[i][1], vh[i][2], vh[i][3]}
            o0 = __builtin_amdgcn_mfma_f32_32x32x16_bf16(pa0, PP_VF(0), o0, 0, 0, 0); o1 = __builtin_amdgcn_mfma_f32_32x32x16_bf16(pa0, PP_VF(4), o1, 0, 0, 0);
            o0 = __builtin_amdgcn_mfma_f32_32x32x16_bf16(pa1, PP_VF(1), o0, 0, 0, 0); o1 = __builtin_amdgcn_mfma_f32_32x32x16_bf16(pa1, PP_VF(5), o1, 0, 0, 0);
            o0 = __builtin_amdgcn_mfma_f32_32x32x16_bf16(pa2, PP_VF(2), o0, 0, 0, 0); o1 = __builtin_amdgcn_mfma_f32_32x32x16_bf16(pa2, PP_VF(6), o1, 0, 0, 0);
            o0 = __builtin_amdgcn_mfma_f32_32x32x16_bf16(pa3, PP_VF(3), o0, 0, 0, 0); o1 = __builtin_amdgcn_mfma_f32_32x32x16_bf16(pa3, PP_VF(7), o1, 0, 0, 0);
            __builtin_amdgcn_s_setprio(0);
        }
        PP_BAR();
        {
            float a = fmaxf(fmaxf(s0[0], s0[1]), s1[0]), b = fmaxf(fmaxf(s0[2], s0[3]), s1[1]); a = fmaxf(fmaxf(a, s1[2]), s1[3]);
#pragma unroll
            for (int r = 4; r < 16; r += 4) { a = fmaxf(fmaxf(a, s0[r]), s0[r + 1]); b = fmaxf(fmaxf(b, s0[r + 2]), s0[r + 3]); a = fmaxf(fmaxf(a, s1[r]), s1[r + 1]); b = fmaxf(fmaxf(b, s1[r + 2]), s1[r + 3]); }
            float rm = fmaxf(a, b);
            { auto rr = __builtin_amdgcn_permlane32_swap(__float_as_uint(rm), __float_as_uint(rm), false, false); rm = fmaxf(__uint_as_float(rr[0]), __uint_as_float(rr[1])); }
            if (__builtin_expect(first || __any(rm > PP_THR), 0)) {
                const float dl = first ? rm : fmaxf(rm, 0.f); mref += dl;
#pragma unroll
                for (int r = 0; r < 16; ++r) { s0[r] -= dl; s1[r] -= dl; }
#pragma unroll
                for (int r = 0; r < 16; ++r) negm[r] = -mref;
                if (!first) { const float f = __builtin_amdgcn_exp2f(-dl); l_reg *= f;
                    if (hi == 0) wsf[r32] = f;
                    asm volatile("s_waitcnt lgkmcnt(0)" ::: "memory");
#pragma unroll
                    for (int r = 0; r < 16; ++r) { const float fr_ = wsf[crow(r, hi)]; o0[r] *= fr_; o1[r] *= fr_; } }
                first = false;
            }
#pragma unroll
            for (int r = 0; r < 16; ++r) { s0[r] = __builtin_amdgcn_exp2f(s0[r]); s1[r] = __builtin_amdgcn_exp2f(s1[r]); }
            float ps = 0.f, ps1 = 0.f;
#pragma unroll
            for (int r = 0; r < 16; ++r) { ps += s0[r]; ps1 += s1[r]; }
            ps += ps1;
            { auto rr = __builtin_amdgcn_permlane32_swap(__float_as_uint(ps), __float_as_uint(ps), false, false); ps = __uint_as_float(rr[0]) + __uint_as_float(rr[1]); }
            l_reg += ps;
#define PP_PK4(Pv, BASE, OUT) do { unsigned a0 = cvt_pk_bf16(Pv[BASE + 0], Pv[BASE + 1]), a1 = cvt_pk_bf16(Pv[BASE + 2], Pv[BASE + 3]);   \
    unsigned b0 = cvt_pk_bf16(Pv[BASE + 4], Pv[BASE + 5]), b1 = cvt_pk_bf16(Pv[BASE + 6], Pv[BASE + 7]);                              \
    auto r0 = __builtin_amdgcn_permlane32_swap(a0, b0, false, false); auto r1 = __builtin_amdgcn_permlane32_swap(a1, b1, false, false); \
    u32x4 w = {r0[0], r1[0], r0[1], r1[1]}; OUT = __builtin_bit_cast(bf16x8, w); } while (0)
            PP_PK4(s0, 0, pa0); PP_PK4(s0, 8, pa1); PP_PK4(s1, 0, pa2); PP_PK4(s1, 8, pa3);
            if (j + 2 < NT) { PP_WRITE(kb_w, vb_w); if (j + 3 < NT) PP_LOAD(j + 3); }
        }
        vb_p = vb_r;
        kb_r = (kb_r == 2 * 16384) ? 0 : kb_r + 16384; vb_r = (vb_r == 3 * 8192) ? 0 : vb_r + 8192;
        kb_w = (kb_w == 2 * 16384) ? 0 : kb_w + 16384; vb_w = (vb_w == 3 * 8192) ? 0 : vb_w + 8192;
        PP_BAR();
    }
    {
        const LAS char* vb = lds + PP_V + vb_p + vrb; s16x4 vl[8], vh[8];
#pragma unroll
        for (int i = 0; i < 8; ++i) { vl[i] = vtr(vb + (i >> 2) * 512 + (i & 3) * 2048); vh[i] = vtr(vb + (i >> 2) * 512 + (i & 3) * 2048 + 1024); }
        o0 = __builtin_amdgcn_mfma_f32_32x32x16_bf16(pa0, PP_VF(0), o0, 0, 0, 0); o1 = __builtin_amdgcn_mfma_f32_32x32x16_bf16(pa0, PP_VF(4), o1, 0, 0, 0);
        o0 = __builtin_amdgcn_mfma_f32_32x32x16_bf16(pa1, PP_VF(1), o0, 0, 0, 0); o1 = __builtin_amdgcn_mfma_f32_32x32x16_bf16(pa1, PP_VF(5), o1, 0, 0, 0);
        o0 = __builtin_amdgcn_mfma_f32_32x32x16_bf16(pa2, PP_VF(2), o0, 0, 0, 0); o1 = __builtin_amdgcn_mfma_f32_32x32x16_bf16(pa2, PP_VF(6), o1, 0, 0, 0);
        o0 = __builtin_amdgcn_mfma_f32_32x32x16_bf16(pa3, PP_VF(3), o0, 0, 0, 0); o1 = __builtin_amdgcn_mfma_f32_32x32x16_bf16(pa3, PP_VF(7), o1, 0, 0, 0);
    }
    if (grp == 0) { __builtin_amdgcn_sched_barrier(0); __builtin_amdgcn_s_barrier(); }
    if (hi == 0) wsf[32 + r32] = l_reg; asm volatile("s_waitcnt lgkmcnt(0)" ::: "memory");
    bf16_t* Ow = P.O + (long)(wid * QBLK) * P.ldo;
#pragma unroll
    for (int r = 0; r < 16; ++r) { const int orow = crow(r, hi); const float rl = __builtin_amdgcn_rcpf(wsf[32 + orow]);
        Ow[(long)orow * P.ldo + r32] = (bf16_t)f2bf(o0[r] * rl); Ow[(long)orow * P.ldo + 32 + r32] = (bf16_t)f2bf(o1[r] * rl); }
    asm volatile("s_waitcnt lgkmcnt(0)" ::: "memory"); __builtin_amdgcn_s_barrier();
#undef PP_LOAD
#undef PP_WRITE
#undef PP_BAR
#undef PP_VF
#undef PP_PK4
}
#undef SBAR
}

constexpr int NWAVES = 8;
constexpr int NPHASES = 18;
enum { P_PRO = 0, P_F1A, P_F1B, P_LN1, P_WIN0, P_UP0, P_ATT0, P_CMB0, P_WIN1, P_UP1, P_ATT1, P_CMB1, P_BR, P_WO, P_LN2, P_F2A, P_F2B, P_LN3 };
constexpr int CW_BAR = 4096;

struct Args { const float* in[24]; float* out; unsigned char* ws; int ph_lo, ph_hi; };
enum { I_X = 0, I_MEM, I_WIN, I_QN, I_KVN, I_WUQ, I_WUKV, I_WMKV, I_WBRA, I_WBRB, I_WBRC, I_WO, I_F1G, I_F1U, I_F1D, I_F2G, I_F2U, I_F2D, I_LN1G, I_LN1B, I_LN2G, I_LN2B, I_LN3G, I_LN3B };

__device__ __forceinline__ float wave_sum(float v, int lane) {
#pragma unroll
    for (int o = 1; o < 64; o <<= 1) v += shx(v, o, lane);
    return v;
}
template <int IL>
__device__ __forceinline__ void transpose_weight(const float* W, int K, int ldw, int col0, int nnb, bf16_t* WT, int drow0, const float* scale, LAS float* scr, int lane, int gw, int NGW, int& off) {
    const int nitems = (K / 64) * nnb;
    for (int it = (gw + NGW - off % NGW) % NGW; it < nitems; it += NGW) {
        const int kb = it / nnb, nb = it % nnb, k0 = 64 * kb, n0 = col0 + 32 * nb;
        const int dr = IL ? drow0 + (nb >> 2) * 256 + (nb & 3) * 32 : drow0 + 32 * nb;
#pragma unroll 8
        for (int i = 0; i < 32; ++i) { const int kk = 2 * i + (lane >> 5); float v = W[(size_t)(k0 + kk) * ldw + n0 + (lane & 31)]; if (scale) v *= scale[k0 + kk]; scr[kk * 33 + (lane & 31)] = v; }
        asm volatile("s_waitcnt lgkmcnt(0)" ::: "memory");
        const int c = lane & 7;
#pragma unroll
        for (int j = 0; j < 4; ++j) { const int n = (lane >> 3) + 8 * j; const LAS float* s = scr + (8 * c) * 33 + n;
            u32x4 o; o.x = pk2(s[0 * 33], s[1 * 33]); o.y = pk2(s[2 * 33], s[3 * 33]); o.z = pk2(s[4 * 33], s[5 * 33]); o.w = pk2(s[6 * 33], s[7 * 33]);
            *(u32x4*)(WT + (size_t)(dr + n) * K + k0 + 8 * c) = o; }
        asm volatile("s_waitcnt lgkmcnt(0)" ::: "memory");
    }
    off += nitems;
}
__device__ __forceinline__ void cvt_rows(const float* a, bf16_t* o, long n8, long gt, long NGT) {
    for (long i = gt; i < n8; i += NGT) { const f32x4 x = *(const f32x4*)(a + i * 8), y = *(const f32x4*)(a + i * 8 + 4);
        u32x4 w; w.x = pk2(x[0], x[1]); w.y = pk2(x[2], x[3]); w.z = pk2(y[0], y[1]); w.w = pk2(y[2], y[3]); *(u32x4*)(o + i * 8) = w; }
}
__device__ __forceinline__ void sincos_d(double a, float& s, float& c) {
    const double k = rint(a * 0.63661977236758134308);
    double r = fma(-k, 1.57079632679489655800, a); r = fma(-k, 6.12323399573676603587e-17, r);
    const double r2 = r * r;
    double sp = -7.6471637318198164759e-13; sp = fma(sp, r2, 1.6059043836821614599e-10); sp = fma(sp, r2, -2.5052108385441718775e-8); sp = fma(sp, r2, 2.7557319223985890653e-6);
    sp = fma(sp, r2, -1.9841269841269841270e-4); sp = fma(sp, r2, 8.3333333333333333333e-3); sp = fma(sp, r2, -1.6666666666666666667e-1); const double sv = fma(sp * r2, r, r);
    double cp = 4.7794773323873852974e-14; cp = fma(cp, r2, -1.1470745597729724714e-11); cp = fma(cp, r2, 2.0876756987868098979e-9); cp = fma(cp, r2, -2.7557319223985890653e-7);
    cp = fma(cp, r2, 2.4801587301587301587e-5); cp = fma(cp, r2, -1.3888888888888888889e-3); cp = fma(cp, r2, 4.1666666666666666667e-2); cp = fma(cp, r2, -0.5); const double cv = fma(cp, r2, 1.0);
    const int q = ((int)k) & 3;
    const double ss = (q & 1) ? cv : sv, cc = (q & 1) ? sv : cv;
    s = (float)((q & 2) ? -ss : ss); c = (float)(((q + 1) & 2) ? -cc : cc);
}
__device__ __forceinline__ void ln_rows(float* z, bf16_t* ob, const float* g, const float* b, int lane, int gw, int NGW) {
    f32x4 gv[4], bv[4];
#pragma unroll
    for (int j = 0; j < 4; ++j) { gv[j] = *((const f32x4*)g + lane + 64 * j); bv[j] = *((const f32x4*)b + lane + 64 * j); }
    for (int m = gw; m < M; m += NGW) {
        f32x4* xr = (f32x4*)(z + (size_t)m * D) + lane;
        f32x4 v[4]; float s = 0.f;
#pragma unroll
        for (int j = 0; j < 4; ++j) { v[j] = xr[64 * j]; s += (v[j].x + v[j].y) + (v[j].z + v[j].w); }
        const float mean = wave_sum(s, lane) * (1.f / D); float s2 = 0.f;
#pragma unroll
        for (int j = 0; j < 4; ++j) { v[j] = v[j] - mean; s2 += (v[j].x * v[j].x + v[j].y * v[j].y) + (v[j].z * v[j].z + v[j].w * v[j].w); }
        const float rstd = 1.f / sqrtf(wave_sum(s2, lane) * (1.f / D) + LN_EPS);
#pragma unroll
        for (int j = 0; j < 4; ++j) { v[j] = v[j] * rstd * gv[j] + bv[j]; xr[64 * j] = v[j]; }
        if (ob) { u32x2* o8 = (u32x2*)(ob + (size_t)m * D) + lane;
#pragma unroll
            for (int j = 0; j < 4; ++j) { u32x2 w; w.x = pk2(v[j].x, v[j].y); w.y = pk2(v[j].z, v[j].w); o8[64 * j] = w; } }
    }
}

__global__ void __launch_bounds__(NWAVES * 64, 2) mega_fwd(Args args) {
    extern __shared__ __attribute__((aligned(16))) unsigned char lds[];
    LAS unsigned char* ldsp = (LAS unsigned char*)lds;
    volatile LAS unsigned* MISC = (volatile LAS unsigned*)(ldsp + MISC_OFF);
    int tl = threadIdx.x;
    const int wave = __builtin_amdgcn_readfirstlane(tl >> 6);
    const int G = gridDim.x, bx = blockIdx.x;
    const int vcu = (G % 8 == 0) ? (bx % 8) * (G / 8) + bx / 8 : bx;
    unsigned char* ws = args.ws;
    unsigned* ctl = (unsigned*)(ws + WS_CTL);
    for (int u = tl; u < (LDS_BYTES - RING_BYTES) / 4; u += NWAVES * 64) ((LAS unsigned*)(ldsp + RING_BYTES))[u] = 0u;
    __syncthreads();
    XcdBarrier bar; bar.bar = ctl + CW_BAR; bar.x = 0; bar.st = nullptr;
    if (!MK_PER_PHASE) bar = xcd_barrier_post(ctl + CW_BAR, MISC + 8, tl);
    const int lo = args.ph_lo, hi = args.ph_hi;
#define LAUNDER() asm volatile("" : "+v"(tl))
#define IN(k) (lo <= (k) && (k) < hi)
#define DUPBAR() do { LAUNDER(); xcd_barrier(bar, tl); LAUNDER(); } while (0)
#define SEAM(k) do { if (IN(k) && IN((k) + 1)) { LAUNDER(); xcd_barrier(bar, tl); } } while (0)
    const int gw = vcu * NWAVES + wave, NGW = G * NWAVES;
    const long NGT = (long)G * NWAVES * 64;
#define GT() ((long)vcu * (NWAVES * 64) + tl)
#define LANE() (tl & 63)

    float* out = args.out;
    bf16_t* AB = (bf16_t*)(ws + WS_AB); bf16_t* HB = (bf16_t*)(ws + WS_H);
    bf16_t* WGU = (bf16_t*)(ws + WS_WGU); bf16_t* WD = (bf16_t*)(ws + WS_WD);
    bf16_t* WIN = (bf16_t*)(ws + WS_WIN); bf16_t* WING = (bf16_t*)(ws + WS_WING);
    bf16_t* WUQ = (bf16_t*)(ws + WS_WUQ); bf16_t* WUKV = (bf16_t*)(ws + WS_WUKV); bf16_t* WMKV = (bf16_t*)(ws + WS_WMKV);
    bf16_t* WBR = (bf16_t*)(ws + WS_WBR); bf16_t* WOt = (bf16_t*)(ws + WS_WO);
    bf16_t* MEMB = (bf16_t*)(ws + WS_MEMB); bf16_t* MEMK = (bf16_t*)(ws + WS_MEMK); bf16_t* MEMV = (bf16_t*)(ws + WS_MEMV);
    float* ROPE = (float*)(ws + WS_ROPE); float* SSQ = (float*)(ws + WS_SSQ); float* SSKV = (float*)(ws + WS_SSKV); float* LSE = (float*)(ws + WS_LSE);
    bf16_t* DIL = (bf16_t*)(ws + WS_DIL); bf16_t* QB = (bf16_t*)(ws + WS_Q); bf16_t* KN = (bf16_t*)(ws + WS_KN); bf16_t* VB = (bf16_t*)(ws + WS_V);
    bf16_t* CQ = (bf16_t*)(ws + WS_CQ); bf16_t* CKV = (bf16_t*)(ws + WS_CKV); bf16_t* KPE = (bf16_t*)(ws + WS_KPE);
    bf16_t* OCAT = (bf16_t*)(ws + WS_OCAT); bf16_t* MLAO = OCAT; bf16_t* DILO = OCAT + (size_t)M * 512; bf16_t* MEMQ = OCAT + (size_t)2 * M * 512;
    bf16_t* MERGED = (bf16_t*)(ws + WS_MERGED);
    LAS float* scr = (LAS float*)(ldsp + wave * 16384);

#define BODY_PRO() do { \
        LAUNDER(); const int lane = LANE(); const long gt = GT(); \
        int off = 0; \
        transpose_weight<1>(args.in[I_F1G], D, DFF, 0, DFF / 32, WGU, 0, nullptr, scr, lane, gw, NGW, off); \
        transpose_weight<1>(args.in[I_F1U], D, DFF, 0, DFF / 32, WGU, 128, nullptr, scr, lane, gw, NGW, off); \
        transpose_weight<0>(args.in[I_F1D], DFF, D, 0, D / 32, WD, 0, nullptr, scr, lane, gw, NGW, off); \
        transpose_weight<0>(args.in[I_WIN], D, IN_COLS, 0, 16, WIN, 0, nullptr, scr, lane, gw, NGW, off); \
        transpose_weight<0>(args.in[I_WIN], D, IN_COLS, 512, 1, WIN, 512, nullptr, scr, lane, gw, NGW, off); \
        transpose_weight<0>(args.in[I_WIN], D, IN_COLS, 544, 144, WIN, 1280, nullptr, scr, lane, gw, NGW, off); \
        transpose_weight<0>(args.in[I_WIN], D, IN_COLS, 5152, 16, WIN, 768, nullptr, scr, lane, gw, NGW, off); \
        transpose_weight<0>(args.in[I_WIN], D, IN_COLS, 5664, 96, WING, 0, nullptr, scr, lane, gw, NGW, off); \
        transpose_weight<0>(args.in[I_WUQ], 256, 768, 0, 24, WUQ, 0, args.in[I_QN], scr, lane, gw, NGW, off); \
        transpose_weight<0>(args.in[I_WUKV], 256, 1024, 0, 32, WUKV, 0, args.in[I_KVN], scr, lane, gw, NGW, off); \
        transpose_weight<0>(args.in[I_WMKV], D, 1024, 0, 32, WMKV, 0, nullptr, scr, lane, gw, NGW, off); \
        transpose_weight<0>(args.in[I_WBRA], 512, D, 0, 32, WBR, 0, nullptr, scr, lane, gw, NGW, off); \
        transpose_weight<0>(args.in[I_WBRB], 512, D, 0, 32, WBR, 1024, nullptr, scr, lane, gw, NGW, off); \
        transpose_weight<0>(args.in[I_WBRC], 512, D, 0, 32, WBR, 2048, nullptr, scr, lane, gw, NGW, off); \
        transpose_weight<0>(args.in[I_WO], D, D, 0, 32, WOt, 0, nullptr, scr, lane, gw, NGW, off); \
        for (long i = gt; i < 224 * 128; i += NGT) *(u32x4*)(WIN + (size_t)544 * D + i * 8) = (u32x4){0u, 0u, 0u, 0u}; \
        cvt_rows(args.in[I_X], AB, (long)M * D / 8, gt, NGT); \
        cvt_rows(args.in[I_MEM], MEMB, 512L * D / 8, gt, NGT); \
        for (long i = gt; i < SEQ * 16; i += NGT) { const int pos = (int)(i >> 4), k = (int)(i & 15); \
            const double inv = exp2(-(double)k * (13.287712379549449 / 16.0)); \
            float s, c; sincos_d((double)pos * inv, s, c); ROPE[i] = c; ROPE[SEQ * 16 + i] = s; } \
 \
    } while (0)
    if (IN(P_PRO)) { BODY_PRO(); if (MK_DUP_PHASE == P_PRO) { DUPBAR(); BODY_PRO(); } }
    if (MK_DUP_PHASE == 100) { DUPBAR(); DUPBAR(); DUPBAR(); DUPBAR(); }
    SEAM(P_PRO);
#define BODY_F1A() do { pg8::Gemm g{AB, WGU, D}; pg8::OrderStd S; S.init(M, 2 * DFF, G, bx); pg8::EpiSwiglu E{HB}; LAUNDER(); pg8::gemm_phase(ldsp, g, S, E, tl); } while (0)
    if (IN(P_F1A)) { BODY_F1A(); if (MK_DUP_PHASE == P_F1A) { DUPBAR(); BODY_F1A(); } }
    SEAM(P_F1A);
#define BODY_F1B() do { pg8::Gemm g{HB, WD, DFF}; pg8::OrderStd S; S.init(M, D, G, bx); pg8::EpiResid E{args.in[I_X], out, ALPHA, 0.5f}; LAUNDER(); pg8::gemm_phase(ldsp, g, S, E, tl); } while (0)
    if (IN(P_F1B)) { BODY_F1B(); if (MK_DUP_PHASE == P_F1B) { DUPBAR(); BODY_F1B(); } }
    SEAM(P_F1B);
    if (IN(P_LN1)) {
        LAUNDER(); const int lane = LANE();
        ln_rows(out, AB, args.in[I_LN1G], args.in[I_LN1B], lane, gw, NGW);
        int off = 0;
        transpose_weight<1>(args.in[I_F2G], D, DFF, 0, DFF / 32, WGU, 0, nullptr, scr, lane, gw, NGW, off);
        transpose_weight<1>(args.in[I_F2U], D, DFF, 0, DFF / 32, WGU, 128, nullptr, scr, lane, gw, NGW, off);
        transpose_weight<0>(args.in[I_F2D], DFF, D, 0, D / 32, WD, 0, nullptr, scr, lane, gw, NGW, off);
    }
    SEAM(P_LN1);
#pragma unroll 1
    for (int b = 0; b < BATCH; ++b) {
        const int PB = P_WIN0 + 4 * b;
        LAUNDER();
#define BODY_WIN() do { \
            { pg8::Gemm g{AB + (size_t)b * SEQ * D, WIN, D}; pg8::OrderStd S; S.init(SEQ, NWIN, G, bx); \
              pg8::EpiWin E{CQ, CKV, KPE, MEMQ + (size_t)b * SEQ * 512, DIL, SSQ, SSKV, ROPE}; LAUNDER(); pg8::gemm_phase(ldsp, g, S, E, tl); } \
            if (b == 0) { pg8::Gemm g{MEMB, WMKV, D}; pg8::OrderStd S; S.init(512, 1024, G, (bx + G - (G >= 232 ? 224 : 0)) % G); pg8::EpiMemKV E{MEMK, MEMV}; LAUNDER(); pg8::gemm_phase(ldsp, g, S, E, tl); } \
 \
    } while (0)
        if (IN(PB)) { BODY_WIN(); if (MK_DUP_PHASE == P_WIN0 && b == 0) { DUPBAR(); BODY_WIN(); } }
        SEAM(PB);
#define BODY_UP() do { \
            { pg8::Gemm g{CQ, WUQ, 256}; pg8::OrderStd S; S.init(SEQ, 768, G, bx); pg8::EpiQup E{QB, SSQ, ROPE}; LAUNDER(); pg8::gemm_phase(ldsp, g, S, E, tl); } \
            { pg8::Gemm g{CKV, WUKV, 256}; pg8::OrderStd S; S.init(SEQ, 1024, G, (bx + G - (G >= 224 ? 96 : 0)) % G); pg8::EpiKVup E{KN, VB, SSKV}; LAUNDER(); pg8::gemm_phase(ldsp, g, S, E, tl); } \
 \
    } while (0)
        if (IN(PB + 1)) { BODY_UP(); if (MK_DUP_PHASE == P_UP0 && b == 0) { DUPBAR(); BODY_UP(); } }
        SEAM(PB + 1);
#define BODY_ATT(ulim_) do { \
            for (int uid = vcu; uid < ulim_; uid += G) { \
                att::Params P{}; \
                if (uid < 256) { const int h = uid >> 5, qb = uid & 31; \
                    P.Q = QB + (size_t)qb * 256 * 768 + h * 96; P.ldq = 768; P.K = KN + h * 64; P.ldk = 512; P.KP = KPE; P.ldkp = 32; P.V = VB + h * 64; P.ldv = 512; \
                    P.O = MLAO + ((size_t)b * SEQ + qb * 256) * 512 + h * 64; P.ldo = 512; P.NT = SEQ / 64; \
                    LAUNDER(); att::mla_unit_pp(P, (LAS char*)ldsp, tl); \
                } else if (uid < 640) { const int id = uid - 256, g = id >> 7, h = (id >> 5) & 3, x = id & 31; \
                    const int dl = (g == 0) ? 1 : (g == 1 ? 4 : 16), nb = 32 / dl, res = x / nb, blk = x % nb, gh = g * 4 + h; \
                    const bf16_t* base = DIL + (size_t)res * 4608 + gh * 128; const long ld = 4608L * dl; \
                    P.Q = base + (size_t)blk * 256 * ld; P.ldq = ld; P.K = base + 1536; P.ldk = ld; P.V = base + 3072; P.ldv = ld; \
                    P.O = (bf16_t*)P.Q; P.ldo = ld; P.LSE = LSE + ((size_t)res + (size_t)blk * 256 * dl) * 12 + gh; P.ldlse = 12L * dl; \
                    P.NT = 6; P.i0 = blk * 256; P.kbase = blk * 256 - 64; P.L = SEQ / dl; \
                    P.slope = exp2f(-8.0f * (float)(gh + 1) / 12.0f) * (float)dl * LOG2E; \
                    LAUNDER(); att::attn_unit<128, 128, 2>(P, (char*)lds, tl); \
                } else { const int id = uid - 640, h = id >> 5, qb = id & 31; \
                    bf16_t* q = MEMQ + ((size_t)b * SEQ + qb * 256) * 512 + h * 128; \
                    P.Q = q; P.ldq = 512; P.K = MEMK + (size_t)b * 256 * 512 + h * 128; P.ldk = 512; P.V = MEMV + (size_t)b * 256 * 512 + h * 128; P.ldv = 512; \
                    P.O = q; P.ldo = 512; P.NT = 4; \
                    LAUNDER(); att::attn_unit<128, 128, 1>(P, (char*)lds, tl); \
                } \
            } \
 \
    } while (0)
        if (IN(PB + 2)) { if (MK_DUP_PHASE == P_ATT0 && b == 0) { BODY_ATT(256); DUPBAR(); } BODY_ATT(768); }
        SEAM(PB + 2);
#define BODY_CMB() do { \
            LAUNDER(); const int lane = LANE(); \
            for (int t = gw; t < SEQ; t += NGW) { \
                const int h = lane >> 4, d8 = (lane & 15) * 8; const float* ls = LSE + (size_t)t * 12 + h; \
                const float l0 = ls[0], l1 = ls[4], l2 = ls[8], mx = fmaxf(l0, fmaxf(l1, l2)); \
                float w0 = __builtin_amdgcn_exp2f(l0 - mx), w1 = __builtin_amdgcn_exp2f(l1 - mx), w2 = __builtin_amdgcn_exp2f(l2 - mx); \
                const float inv = 1.0f / (w0 + w1 + w2); w0 *= inv; w1 *= inv; w2 *= inv; \
                const bf16_t* src = DIL + (size_t)t * 4608 + h * 128 + d8; \
                const u32x4 a = *(const u32x4*)src, bq = *(const u32x4*)(src + 512), c = *(const u32x4*)(src + 1024); \
                u32x4 o; \
                o.x = pk2(w0 * bf_lo(a.x) + w1 * bf_lo(bq.x) + w2 * bf_lo(c.x), w0 * bf_hi(a.x) + w1 * bf_hi(bq.x) + w2 * bf_hi(c.x)); \
                o.y = pk2(w0 * bf_lo(a.y) + w1 * bf_lo(bq.y) + w2 * bf_lo(c.y), w0 * bf_hi(a.y) + w1 * bf_hi(bq.y) + w2 * bf_hi(c.y)); \
                o.z = pk2(w0 * bf_lo(a.z) + w1 * bf_lo(bq.z) + w2 * bf_lo(c.z), w0 * bf_hi(a.z) + w1 * bf_hi(bq.z) + w2 * bf_hi(c.z)); \
                o.w = pk2(w0 * bf_lo(a.w) + w1 * bf_lo(bq.w) + w2 * bf_lo(c.w), w0 * bf_hi(a.w) + w1 * bf_hi(bq.w) + w2 * bf_hi(c.w)); \
                *(u32x4*)(DILO + ((size_t)b * SEQ + t) * 512 + h * 128 + d8) = o; \
            } \
 \
    } while (0)
        if (IN(PB + 3)) { BODY_CMB(); if (MK_DUP_PHASE == P_CMB0 && b == 0) { DUPBAR(); BODY_CMB(); } }
        SEAM(PB + 3);
    }
#define BODY_BR() do { \
        u32x4* GT = (u32x4*)(ws + WS_GATES) + (size_t)bx * 3 * 16 * 512; \
        { pg8::Gemm g{AB, WING, D}; pg8::OrderTri<0> S; S.base.init(M, D, G, bx); pg8::EpiGate E{GT}; LAUNDER(); pg8::gemm_phase(ldsp, g, S, E, tl); } \
        { pg8::Gemm g{OCAT, WBR, 512}; pg8::OrderTri<1> S; S.base.init(M, D, G, bx); pg8::EpiBranch E{GT, MERGED}; LAUNDER(); pg8::gemm_phase(ldsp, g, S, E, tl); } \
 \
    } while (0)
    if (IN(P_BR)) { BODY_BR(); if (MK_DUP_PHASE == P_BR) { DUPBAR(); BODY_BR(); } }
    SEAM(P_BR);
    if (IN(P_WO)) { pg8::Gemm g{MERGED, WOt, D}; pg8::OrderStd S; S.init(M, D, G, bx); pg8::EpiResid E{out, out, ALPHA, 1.0f}; LAUNDER(); pg8::gemm_phase(ldsp, g, S, E, tl); }
    SEAM(P_WO);
    if (IN(P_LN2)) { LAUNDER(); ln_rows(out, AB, args.in[I_LN2G], args.in[I_LN2B], LANE(), gw, NGW); }
    SEAM(P_LN2);
    if (IN(P_F2A)) { pg8::Gemm g{AB, WGU, D}; pg8::OrderStd S; S.init(M, 2 * DFF, G, bx); pg8::EpiSwiglu E{HB}; LAUNDER(); pg8::gemm_phase(ldsp, g, S, E, tl); }
    SEAM(P_F2A);
    if (IN(P_F2B)) { pg8::Gemm g{HB, WD, DFF}; pg8::OrderStd S; S.init(M, D, G, bx); pg8::EpiResid E{out, out, ALPHA, 0.5f}; LAUNDER(); pg8::gemm_phase(ldsp, g, S, E, tl); }
    SEAM(P_F2B);
    if (IN(P_LN3)) { LAUNDER(); ln_rows(out, nullptr, args.in[I_LN3G], args.in[I_LN3B], LANE(), gw, NGW); }
#undef IN
#undef SEAM
}

extern "C" void kernel_launch(void* const* d_in, const int* in_sizes, int n_in, void* d_out, int out_size, void* d_ws, size_t ws_size, hipStream_t stream) {
    static int grid = 0;
    if (grid == 0) {
        if (n_in != 24 || in_sizes[0] != M * D || out_size != M * D || ws_size < WS_END) { fprintf(stderr, "kernel_launch: shape mismatch n_in %d in0 %d out %d ws %zu\n", n_in, n_in > 0 ? in_sizes[0] : -1, out_size, ws_size); grid = -1; return; }
        int dev = 0, cus = 0, per_cu = 0;
        if (hipGetDevice(&dev) != hipSuccess || hipDeviceGetAttribute(&cus, hipDeviceAttributeMultiprocessorCount, dev) != hipSuccess) { grid = -1; return; }
        if (hipFuncSetAttribute((const void*)mega_fwd, hipFuncAttributeMaxDynamicSharedMemorySize, LDS_BYTES) != hipSuccess) { fprintf(stderr, "kernel_launch: hipFuncSetAttribute failed\n"); grid = -1; return; }
        if (hipOccupancyMaxActiveBlocksPerMultiprocessor(&per_cu, (const void*)mega_fwd, NWAVES * 64, LDS_BYTES) != hipSuccess || per_cu < 1) { fprintf(stderr, "kernel_launch: occupancy query says %d\n", per_cu); }
        (void)hipGetLastError();
        grid = cus;
        if (grid != 256) fprintf(stderr, "kernel_launch: %d CUs (built for 256)\n", grid);
    }
    if (grid < 0) return;
    if (hipMemsetAsync((char*)d_ws + WS_CTL, 0, CTL_ZERO_BYTES, stream) != hipSuccess) return;
    Args a{};
    for (int i = 0; i < 24; ++i) a.in[i] = (const float*)d_in[i];
    a.out = (float*)d_out; a.ws = (unsigned char*)d_ws;
#if MK_PER_PHASE
    for (int p = 0; p < MK_PH_END; ++p) { a.ph_lo = p; a.ph_hi = p + 1; hipLaunchKernelGGL(mega_fwd, dim3(grid), dim3(NWAVES * 64), LDS_BYTES, stream, a); }
#else
    a.ph_lo = 0; a.ph_hi = MK_PH_END;
    void* kargs[] = {&a};
    hipError_t e = hipLaunchCooperativeKernel((const void*)mega_fwd, dim3(grid), dim3(NWAVES * 64), kargs, LDS_BYTES, stream);
    if (e != hipSuccess) fprintf(stderr, "kernel_launch: cooperative launch failed: %s (grid %d)\n", hipGetErrorString(e), grid);
#endif
}
```
